# Optimizing an MI355X kernel written in HIP

```python
import jax, jax.numpy as jnp
from jax import lax
import numpy as np

D_MODEL = 2048
BATCH = 1
SEQ = 8192
DEPTH = 4

N_MIXERS = 3
HEAD_DIM = 128
N_HEADS = D_MODEL // HEAD_DIM
FFN_DIM = -(-(8 * D_MODEL // 3) // 256) * 256
CONV_WIDTH = 3
Q_BLOCK = 128
NORM_EPS = 1e-6
N_FOX = (DEPTH + 2) // 3
N_CONV = (DEPTH + 1) // 3
N_SB = DEPTH // 3

kernel_name = "hybrid_fox_shortconv_stickbreaking_macaron"


def rms_norm(x, g):
    xf = x.astype(jnp.float32)
    y = xf * lax.rsqrt(jnp.mean(xf * xf, axis=-1, keepdims=True) + NORM_EPS)
    return (y * g.astype(jnp.float32)).astype(x.dtype)


def swiglu(x, w_gate, w_up, w_down):
    return (jax.nn.silu(x @ w_gate) * (x @ w_up)) @ w_down


def split_heads(t):
    b, s, _ = t.shape
    return t.reshape(b, s, N_HEADS, HEAD_DIM).transpose(0, 2, 1, 3)


def to_query_blocks(t):
    b, h, s, d = t.shape
    return jnp.moveaxis(t.reshape(b, h, s // Q_BLOCK, Q_BLOCK, d), 2, 0)


def from_query_blocks(o):
    nb, b, h, qb, d = o.shape
    o = jnp.moveaxis(o, 0, 2).reshape(b, h, nb * qb, d)
    return o.transpose(0, 2, 1, 3).reshape(b, nb * qb, h * d)


def fox_mixer(h, w_in, b_f, q_gain, k_gain, w_out):
    b, s, _ = h.shape
    proj = h @ w_in
    q, k, v, f_logit = jnp.split(proj, [D_MODEL, 2 * D_MODEL, 3 * D_MODEL], axis=-1)
    q = rms_norm(q.reshape(b, s, N_HEADS, HEAD_DIM), q_gain)
    k = rms_norm(k.reshape(b, s, N_HEADS, HEAD_DIM), k_gain)
    log_f = jax.nn.log_sigmoid((f_logit + b_f).astype(jnp.float32))
    c = jnp.cumsum(log_f, axis=1).transpose(0, 2, 1)
    qh = q.transpose(0, 2, 1, 3).astype(jnp.float32)
    kh = k.transpose(0, 2, 1, 3).astype(jnp.float32)
    vh = split_heads(v)
    nb = s // Q_BLOCK
    q_blocks = to_query_blocks(qh)
    c_blocks = jnp.moveaxis(c.reshape(b, N_HEADS, nb, Q_BLOCK), 2, 0)
    key_pos = jnp.arange(s)
    scale = HEAD_DIM ** -0.5

    def one_block(args):
        qb, cb, i = args
        q_pos = i * Q_BLOCK + jnp.arange(Q_BLOCK)
        logits = jnp.einsum('bhqd,bhkd->bhqk', qb, kh) * scale
        logits = logits + cb[..., None] - c[:, :, None, :]
        logits = jnp.where(key_pos[None, :] <= q_pos[:, None], logits, -jnp.inf)
        p = jax.nn.softmax(logits, axis=-1)
        return jnp.einsum('bhqk,bhkd->bhqd', p.astype(vh.dtype), vh)

    o = lax.map(one_block, (q_blocks, c_blocks, jnp.arange(nb)))
    return from_query_blocks(o) @ w_out


def conv_mixer(h, w_in, conv_kernel, w_out):
    proj = h @ w_in
    b_gate, c_gate, u = jnp.split(proj, 3, axis=-1)
    inner = c_gate * u
    conv = lax.conv_general_dilated(
        inner, conv_kernel[:, None, :].astype(inner.dtype),
        window_strides=(1,), padding=[(CONV_WIDTH - 1, 0)],
        dimension_numbers=('NWC', 'WIO', 'NWC'),
        feature_group_count=D_MODEL)
    return (b_gate * conv) @ w_out


def stick_breaking_mixer(h, w_in, w_out):
    b, s, _ = h.shape
    proj = h @ w_in
    q, k, v = jnp.split(proj, 3, axis=-1)
    qh = split_heads(q).astype(jnp.float32)
    kh = split_heads(k).astype(jnp.float32)
    vh = split_heads(v)
    nb = s // Q_BLOCK
    q_blocks = to_query_blocks(qh)
    key_pos = jnp.arange(s)
    scale = HEAD_DIM ** -0.5

    def one_block(args):
        qb, i = args
        q_pos = i * Q_BLOCK + jnp.arange(Q_BLOCK)
        z = jnp.einsum('bhqd,bhkd->bhqk', qb, kh) * scale
        strict = key_pos[None, :] < q_pos[:, None]
        log_beta = jax.nn.log_sigmoid(z)
        log_one_minus = jnp.where(strict, jax.nn.log_sigmoid(-z), 0.0)
        between = lax.cumsum(log_one_minus, axis=3, reverse=True) - log_one_minus
        a = jnp.where(strict, jnp.exp(log_beta + between), 0.0)
        return jnp.einsum('bhqk,bhkd->bhqd', a.astype(vh.dtype), vh)

    o = lax.map(one_block, (q_blocks, jnp.arange(nb)))
    return from_query_blocks(o) @ w_out


def setup_inputs(seed: int = 0) -> dict:
    key = jax.random.key(seed)
    ks = jax.random.split(key, 24)
    f32 = jnp.float32
    d, f, hd, h = D_MODEL, FFN_DIM, HEAD_DIM, N_HEADS

    def nrm(k, shape, fan_in):
        return jax.random.normal(k, shape, f32) * (fan_in ** -0.5)

    def gain(k, shape):
        return 1.0 + 0.05 * jax.random.normal(k, shape, f32)

    return {
        "x": jax.random.normal(ks[0], (BATCH, SEQ, d), f32),
        "norm_ffn1": gain(ks[1], (DEPTH, d)),
        "norm_mix": gain(ks[2], (DEPTH, d)),
        "norm_ffn2": gain(ks[3], (DEPTH, d)),
        "ffn1_w_gate": nrm(ks[4], (DEPTH, d, f), d),
        "ffn1_w_up": nrm(ks[5], (DEPTH, d, f), d),
        "ffn1_w_down": nrm(ks[6], (DEPTH, f, d), f),
        "ffn2_w_gate": nrm(ks[7], (DEPTH, d, f), d),
        "ffn2_w_up": nrm(ks[8], (DEPTH, d, f), d),
        "ffn2_w_down": nrm(ks[9], (DEPTH, f, d), f),
        "fox_w_in": nrm(ks[10], (N_FOX, d, 3 * d + h), d),
        "fox_b_f": jax.random.uniform(ks[11], (N_FOX, h), f32, 1.0, 4.0),
        "fox_q_gain": gain(ks[12], (N_FOX, hd)),
        "fox_k_gain": gain(ks[13], (N_FOX, hd)),
        "fox_w_out": nrm(ks[14], (N_FOX, d, d), d),
        "conv_w_in": nrm(ks[15], (N_CONV, d, 3 * d), d),
        "conv_kernel": nrm(ks[16], (N_CONV, CONV_WIDTH, d), CONV_WIDTH),
        "conv_w_out": nrm(ks[17], (N_CONV, d, d), d),
        "sb_w_in": nrm(ks[18], (N_SB, d, 3 * d), d),
        "sb_w_out": nrm(ks[19], (N_SB, d, d), d),
    }


def reference(x, norm_ffn1, norm_mix, norm_ffn2,
              ffn1_w_gate, ffn1_w_up, ffn1_w_down,
              ffn2_w_gate, ffn2_w_up, ffn2_w_down,
              fox_w_in, fox_b_f, fox_q_gain, fox_k_gain, fox_w_out,
              conv_w_in, conv_kernel, conv_w_out,
              sb_w_in, sb_w_out):
    for i in range(DEPTH):
        x = x + 0.5 * swiglu(rms_norm(x, norm_ffn1[i]), ffn1_w_gate[i], ffn1_w_up[i], ffn1_w_down[i])
        hn = rms_norm(x, norm_mix[i])
        kind, j = i % N_MIXERS, i // N_MIXERS
        if kind == 0:
            m = fox_mixer(hn, fox_w_in[j], fox_b_f[j], fox_q_gain[j], fox_k_gain[j], fox_w_out[j])
        elif kind == 1:
            m = conv_mixer(hn, conv_w_in[j], conv_kernel[j], conv_w_out[j])
        else:
            m = stick_breaking_mixer(hn, sb_w_in[j], sb_w_out[j])
        x = x + m
        x = x + 0.5 * swiglu(rms_norm(x, norm_ffn2[i]), ffn2_w_gate[i], ffn2_w_up[i], ffn2_w_down[i])
    return x
```

```cpp
#include <hip/hip_runtime.h>
#include <cstdio>
#include <cstdint>
#ifndef MK_ONE_LAUNCH
#define MK_ONE_LAUNCH 1
#endif
#ifndef MK_NAIVE_ATTN
#define MK_NAIVE_ATTN 0
#endif
namespace pg8 {
#define PG8_LAS __attribute__((address_space(3)))
typedef unsigned short bf16_t;
typedef short bf16x8 __attribute__((ext_vector_type(8)));
typedef float f32x4 __attribute__((ext_vector_type(4)));
typedef unsigned u32x4 __attribute__((ext_vector_type(4)));
constexpr int BM = 256, BK = 64, HALF = 128, HTB = HALF * BK * 2  , STAGE_BYTES = 8 * HTB, NXCD = 8, WGM = 8;

__host__ __device__ __forceinline__ int lds_byte(int r, int c) { const int st = (r >> 4) * 2 + (c >> 5), rr = r & 15, cc = c & 31, ob = rr * 64 + cc * 2; return st * 1024 + (ob ^ (((ob >> 9) & 1) << 5)); }
__host__ __device__ __forceinline__ void stage_rc(int b, int& R, int& C) { const int st = b / 1024, sb = b % 1024, swz = sb ^ (((sb >> 9) & 1) << 5); R = (st >> 1) * 16 + swz / 64; C = (st & 1) * 32 + (swz % 64) / 2; }
__host__ __device__ __forceinline__ int perm32(int rho) { const int n = rho >> 4, i = rho & 15; return 8 * (i >> 2) + 4 * n + (i & 3); }

struct Unit { int pm, pn; };
struct Gemm { const bf16_t* A; const bf16_t* Bt; int M, N, K; };

struct StaticOrder {
    int nM, nN, nwg, G, c;
    __host__ __device__ void init(int M, int N, int G_, int c_) { nM = M / BM; nN = N / BM; nwg = nM * nN; G = G_; c = c_; }
    __host__ __device__ bool next(int i, Unit& u) const {
        const long L = (long)i * G + c; if (L >= nwg) return false;
        int wgid = (int)L; { const int q = nwg / NXCD, r = nwg % NXCD, xcd = wgid % NXCD, off = wgid / NXCD; wgid = (xcd < r ? xcd * (q + 1) : r * (q + 1) + (xcd - r) * q) + off; }
        const int nig = WGM * nN, gid = wgid / nig, fm = gid * WGM, gsz = (nM - fm) < WGM ? (nM - fm) : WGM;
        u.pm = fm + ((wgid % nig) % gsz); u.pn = (wgid % nig) / gsz; return true;
    }
    __device__ __forceinline__ void a_ready(const Unit&) const {}
    __device__ __forceinline__ void done(const Unit&) const {}
};


__device__ __forceinline__ unsigned cvt_pk_bf16(float lo, float hi) { unsigned r; asm volatile("v_cvt_pk_bf16_f32 %0, %1, %2" : "=v"(r) : "v"(lo), "v"(hi)); return r; }
constexpr float NORM_EPS = 1e-6f, INV_D = 1.0f / 2048.0f, SS_FIX = 16777216.0f, SS_UNFIX = 1.0f / 16777216.0f;
typedef unsigned long long u64_t;
__device__ __forceinline__ float ss_rstd(const u64_t* ss, int row) { return __builtin_amdgcn_rsqf((float)ss[row] * (SS_UNFIX * INV_D) + NORM_EPS); }
__device__ __forceinline__ float silu_mul(float g, float u) {
    const float e = __builtin_amdgcn_exp2f(g * -1.4426950408889634f);
    return g * u * __builtin_amdgcn_rcpf(1.0f + e);
}
struct EpiSwiglu {
    static constexpr bool PERM = true, AFTER_DRAIN = false;
    bf16_t* O; int ldc; const u64_t* ss;
    __device__ __forceinline__ void operator()(const f32x4 (&acc)[2][2][4][2], const Unit& u, int wr, int wc, int fr, int fq) const {
        const int row0 = u.pm * BM + wr * 64 + fr, col0 = u.pn * HALF + wc * 32 + 8 * fq;
#pragma unroll
        for (int ai = 0; ai < 2; ++ai)
#pragma unroll
            for (int m = 0; m < 4; ++m) { const int row = row0 + ai * HALF + m * 16;
                const float rs = ss_rstd(ss, row);
                const f32x4 g0 = acc[ai][0][m][0] * rs, g1 = acc[ai][0][m][1] * rs, u0 = acc[ai][1][m][0] * rs, u1 = acc[ai][1][m][1] * rs;
                u32x4 w; w.x = cvt_pk_bf16(silu_mul(g0[0], u0[0]), silu_mul(g0[1], u0[1])); w.y = cvt_pk_bf16(silu_mul(g0[2], u0[2]), silu_mul(g0[3], u0[3]));
                w.z = cvt_pk_bf16(silu_mul(g1[0], u1[0]), silu_mul(g1[1], u1[1])); w.w = cvt_pk_bf16(silu_mul(g1[2], u1[2]), silu_mul(g1[3], u1[3]));
                *(u32x4*)(O + (size_t)row * ldc + col0) = w; }
    }
};
struct EpiQKV {
    static constexpr bool PERM = true, AFTER_DRAIN = false;
    bf16_t* O; int ldc; const u64_t* ss; float qscale; int qtiles;
    __device__ __forceinline__ void operator()(const f32x4 (&acc)[2][2][4][2], const Unit& u, int wr, int wc, int fr, int fq) const {
        const int row0 = u.pm * BM + wr * 64 + fr, col0 = u.pn * BM + wc * 32 + 8 * fq;
        const float sc = (u.pn < qtiles) ? qscale : 1.0f;
#pragma unroll
        for (int ai = 0; ai < 2; ++ai)
#pragma unroll
            for (int m = 0; m < 4; ++m) { const int row = row0 + ai * HALF + m * 16;
                const float rs = ss_rstd(ss, row) * sc;
#pragma unroll
                for (int bj = 0; bj < 2; ++bj) { const f32x4 v0 = acc[ai][bj][m][0] * rs, v1 = acc[ai][bj][m][1] * rs;
                    u32x4 w; w.x = cvt_pk_bf16(v0[0], v0[1]); w.y = cvt_pk_bf16(v0[2], v0[3]); w.z = cvt_pk_bf16(v1[0], v1[1]); w.w = cvt_pk_bf16(v1[2], v1[3]);
                    *(u32x4*)(O + (size_t)row * ldc + col0 + bj * HALF) = w; } }
    }
};
struct EpiResid {
    static constexpr bool PERM = false, AFTER_DRAIN = false;
    float* X; bf16_t* XB; u64_t* ss_out; float alpha;
    __device__ __forceinline__ void operator()(const f32x4 (&acc)[2][2][4][2], const Unit& u, int wr, int wc, int fr, int fq) const {
        typedef unsigned u32x2v __attribute__((ext_vector_type(2)));
        const int row0 = u.pm * BM + wr * 64 + fr, col0 = u.pn * BM + wc * 32 + 4 * fq;
#pragma unroll
        for (int ai = 0; ai < 2; ++ai)
#pragma unroll
            for (int m = 0; m < 4; ++m) { const int row = row0 + ai * HALF + m * 16; const size_t off = (size_t)row * 2048 + col0; float sq = 0.f;
                f32x4 xo[2][2];
#pragma unroll
                for (int bj = 0; bj < 2; ++bj)
#pragma unroll
                    for (int n = 0; n < 2; ++n) xo[bj][n] = *(const f32x4*)(X + off + bj * HALF + n * 16);
#pragma unroll
                for (int bj = 0; bj < 2; ++bj)
#pragma unroll
                    for (int n = 0; n < 2; ++n) { const f32x4 xn = xo[bj][n] + acc[ai][bj][m][n] * alpha;
                        *(f32x4*)(X + off + bj * HALF + n * 16) = xn; sq += (xn[0] * xn[0] + xn[1] * xn[1]) + (xn[2] * xn[2] + xn[3] * xn[3]);
                        u32x2v w; w.x = cvt_pk_bf16(xn[0], xn[1]); w.y = cvt_pk_bf16(xn[2], xn[3]); *(u32x2v*)(XB + off + bj * HALF + n * 16) = w; }
                sq += __shfl_xor(sq, 16); sq += __shfl_xor(sq, 32);
                if (fq == 0) __hip_atomic_fetch_add(ss_out + row, (u64_t)(sq * SS_FIX), __ATOMIC_RELAXED, __HIP_MEMORY_SCOPE_AGENT); }
    }
};
template <class Epi, class Sched, bool ALIGN_EPI = false, bool SP2 = false>
__device__ __forceinline__ void gemm_phase(PG8_LAS unsigned char* lds, const Gemm g, const Sched& S, const Epi& E) {
    int tid_ = threadIdx.x; asm volatile("" : "+v"(tid_));
    const int tid = tid_, wid = __builtin_amdgcn_readfirstlane(tid >> 6), lane = tid & 63, wr = wid >> 2, wc = wid & 3, fr = lane & 15, fq = lane >> 4;
    const int K = g.K, nt = K / BK;
    unsigned voffA[2], voffB[2];
#pragma unroll
    for (int i = 0; i < 2; ++i) { int R, C; stage_rc(tid * 16 + i * 8192, R, C); const int Rb = Epi::PERM ? ((R & ~31) + perm32(R & 31)) : R;
        voffA[i] = (unsigned)(R * K + C) * 2u; voffB[i] = (unsigned)(Rb * K + C) * 2u; }
    const size_t kstep = (size_t)(BK * 2);
    const size_t hstep = (size_t)HALF * K * 2;
    const size_t tstep = 2 * hstep;
    const unsigned ldsw = (unsigned)wid * 1024u;
    const int aoff = lds_byte(wr * 64 + fr, fq * 8), boff = lds_byte(wc * 32 + fr, fq * 8);
#define PG8_SA(b, h) (((b) * 2 + (h)) * HTB)
#define PG8_SB(b, h) ((4 + (b) * 2 + (h)) * HTB)
#define PG8_STAGE(bufoff, gbase, voff) do { _Pragma("unroll") for (int _i = 0; _i < 2; ++_i) \
        __builtin_amdgcn_global_load_lds((const unsigned*)((const char*)(gbase) + (voff)[_i]), (PG8_LAS unsigned*)(lds + (bufoff) + ldsw + _i * 8192), 16, 0, 0); } while (0)
#define PG8_LDA(dst, b, h) do { _Pragma("unroll") for (int m = 0; m < 4; ++m) _Pragma("unroll") for (int k = 0; k < 2; ++k) dst[m][k] = *(const PG8_LAS bf16x8*)(lds + PG8_SA(b, h) + aoff + m * 2048 + k * 1024); } while (0)
#define PG8_LDB(dst, b, h) do { _Pragma("unroll") for (int n = 0; n < 2; ++n) _Pragma("unroll") for (int k = 0; k < 2; ++k) dst[n][k] = *(const PG8_LAS bf16x8*)(lds + PG8_SB(b, h) + boff + n * 2048 + k * 1024); } while (0)
#define PG8_MMA(ai, bj, At, Bt) do { __builtin_amdgcn_s_setprio(1); _Pragma("unroll") for (int m = 0; m < 4; ++m) _Pragma("unroll") for (int n = 0; n < 2; ++n) _Pragma("unroll") for (int k = 0; k < 2; ++k) \
        acc[ai][bj][m][n] = __builtin_amdgcn_mfma_f32_16x16x32_bf16(Bt[n][k], At[m][k], acc[ai][bj][m][n], 0, 0, 0); __builtin_amdgcn_s_setprio(0); } while (0)
#define PG8_WAIT_V(n) asm volatile("s_waitcnt vmcnt(" #n ")" ::: "memory")
#define PG8_WAIT_L(n) asm volatile("s_waitcnt lgkmcnt(" #n ")" ::: "memory")
#define PG8_BAR __builtin_amdgcn_s_barrier()
#define PG8_SCHED __builtin_amdgcn_sched_barrier(0)
    Unit cur, nxt; int ui = 0;
    if (!S.next(0, cur)) return;
    f32x4 acc[2][2][4][2];
#pragma unroll
    for (int a = 0; a < 2; ++a)
#pragma unroll
        for (int b = 0; b < 2; ++b)
#pragma unroll
            for (int m = 0; m < 4; ++m)
#pragma unroll
                for (int n = 0; n < 2; ++n) acc[a][b][m][n] = (f32x4){0.f, 0.f, 0.f, 0.f};
    bf16x8 At[4][2], B0[2][2], B1[2][2];
    const char* cA = (const char*)g.A + (size_t)cur.pm * tstep; const char* cB = (const char*)g.Bt + (size_t)cur.pn * tstep;
    S.a_ready(cur);
    if constexpr (SP2) {
        PG8_STAGE(PG8_SB(0, 0), cB, voffB); PG8_STAGE(PG8_SB(0, 1), cB + hstep, voffB); PG8_STAGE(PG8_SA(0, 0), cA, voffA); PG8_STAGE(PG8_SA(0, 1), cA + hstep, voffA);
        if (wr == 1) PG8_BAR;
        PG8_WAIT_V(2); PG8_BAR;
        PG8_STAGE(PG8_SB(1, 0), cB + kstep, voffB); PG8_STAGE(PG8_SA(1, 0), cA + kstep, voffA); PG8_STAGE(PG8_SB(1, 1), cB + hstep + kstep, voffB);
        PG8_WAIT_V(6); PG8_BAR;
    } else {
        PG8_STAGE(PG8_SB(0, 0), cB, voffB); PG8_STAGE(PG8_SA(0, 0), cA, voffA); PG8_STAGE(PG8_SB(0, 1), cB + hstep, voffB); PG8_STAGE(PG8_SA(0, 1), cA + hstep, voffA);
        if (wr == 1) PG8_BAR;
        PG8_WAIT_V(4); PG8_BAR;
        PG8_STAGE(PG8_SB(1, 0), cB + kstep, voffB); PG8_STAGE(PG8_SA(1, 0), cA + kstep, voffA); PG8_STAGE(PG8_SB(1, 1), cB + hstep + kstep, voffB);
        PG8_WAIT_V(6); PG8_BAR;
    }
    for (;;) {
        const bool has_next = S.next(ui + 1, nxt);
        const char* nA = has_next ? (const char*)g.A + (size_t)nxt.pm * tstep : cA; const char* nB = has_next ? (const char*)g.Bt + (size_t)nxt.pn * tstep : cB;
        for (int t = 0; t < nt; t += 2) {
            const bool last = (t == nt - 2);
            const char* a1 = cA + (size_t)(t + 1) * kstep;
            const char* a2 = last ? nA : cA + (size_t)(t + 2) * kstep; const char* b2 = last ? nB : cB + (size_t)(t + 2) * kstep;
            const char* a3 = a2 + kstep; const char* b3 = b2 + kstep;
            if (last && has_next) S.a_ready(nxt);
            if constexpr (SP2) {
            PG8_LDB(B0, 0, 0); PG8_LDB(B1, 0, 1); PG8_SCHED; PG8_LDA(At, 0, 0); PG8_STAGE(PG8_SA(1, 1), a1 + hstep, voffA);
            PG8_WAIT_V(8); PG8_WAIT_L(0); PG8_BAR; PG8_MMA(0, 0, At, B0); PG8_MMA(0, 1, At, B1); PG8_BAR; PG8_SCHED;
            PG8_LDA(At, 0, 1); PG8_STAGE(PG8_SB(0, 0), b2, voffB); PG8_STAGE(PG8_SB(0, 1), b2 + hstep, voffB); PG8_STAGE(PG8_SA(0, 0), a2, voffA);
            PG8_WAIT_V(8); PG8_WAIT_L(0); PG8_BAR; PG8_MMA(1, 0, At, B0); PG8_MMA(1, 1, At, B1); PG8_BAR; PG8_SCHED;
            PG8_LDB(B0, 1, 0); PG8_LDB(B1, 1, 1); PG8_SCHED; PG8_LDA(At, 1, 0); PG8_STAGE(PG8_SA(0, 1), a2 + hstep, voffA);
            PG8_WAIT_V(8); PG8_WAIT_L(0); PG8_BAR; PG8_MMA(0, 0, At, B0); PG8_MMA(0, 1, At, B1); PG8_BAR; PG8_SCHED;
            PG8_LDA(At, 1, 1); PG8_STAGE(PG8_SB(1, 0), b3, voffB); PG8_STAGE(PG8_SB(1, 1), b3 + hstep, voffB); PG8_STAGE(PG8_SA(1, 0), a3, voffA);
            PG8_WAIT_V(8); PG8_WAIT_L(0); PG8_BAR; PG8_MMA(1, 0, At, B0); PG8_MMA(1, 1, At, B1); PG8_BAR; PG8_SCHED;
            } else {
            PG8_LDB(B0, 0, 0); PG8_SCHED; PG8_LDA(At, 0, 0); PG8_STAGE(PG8_SA(1, 1), a1 + hstep, voffA);
            PG8_WAIT_L(8); PG8_BAR; PG8_WAIT_L(0); PG8_MMA(0, 0, At, B0); PG8_BAR; PG8_SCHED;
            PG8_LDB(B1, 0, 1); PG8_STAGE(PG8_SB(0, 0), b2, voffB);
            PG8_BAR; PG8_WAIT_L(0); PG8_MMA(0, 1, At, B1); PG8_BAR;
            PG8_LDA(At, 0, 1); PG8_STAGE(PG8_SA(0, 0), a2, voffA);
            PG8_BAR; PG8_WAIT_L(0); PG8_MMA(1, 0, At, B0); PG8_BAR; PG8_SCHED;
            PG8_STAGE(PG8_SB(0, 1), b2 + hstep, voffB);
            PG8_WAIT_V(6); PG8_BAR; PG8_MMA(1, 1, At, B1); PG8_BAR;
            PG8_LDB(B0, 1, 0); PG8_SCHED; PG8_LDA(At, 1, 0); PG8_STAGE(PG8_SA(0, 1), a2 + hstep, voffA);
            PG8_WAIT_L(8); PG8_BAR; PG8_WAIT_L(0); PG8_MMA(0, 0, At, B0); PG8_BAR; PG8_SCHED;
            PG8_LDB(B1, 1, 1); PG8_STAGE(PG8_SB(1, 0), b3, voffB);
            PG8_BAR; PG8_WAIT_L(0); PG8_MMA(0, 1, At, B1); PG8_BAR;
            PG8_LDA(At, 1, 1); PG8_STAGE(PG8_SA(1, 0), a3, voffA);
            PG8_BAR; PG8_WAIT_L(0); PG8_MMA(1, 0, At, B0); PG8_BAR; PG8_SCHED;
            PG8_STAGE(PG8_SB(1, 1), b3 + hstep, voffB);
            PG8_WAIT_V(6); PG8_BAR; PG8_MMA(1, 1, At, B1); PG8_BAR;
            }
        }
        if constexpr (ALIGN_EPI) { if (wr == 0) PG8_BAR; }
        if constexpr (!Epi::AFTER_DRAIN) { E(acc, cur, wr, wc, fr, fq); S.done(cur); }
        if (!has_next) break;
#pragma unroll
        for (int a = 0; a < 2; ++a)
#pragma unroll
            for (int b = 0; b < 2; ++b)
#pragma unroll
                for (int m = 0; m < 4; ++m)
#pragma unroll
                    for (int n = 0; n < 2; ++n) acc[a][b][m][n] = (f32x4){0.f, 0.f, 0.f, 0.f};
        cur = nxt; cA = nA; cB = nB; ++ui;
        if constexpr (ALIGN_EPI) { if (wr == 1) PG8_BAR; }
    }
    PG8_WAIT_V(0);
    if constexpr (!ALIGN_EPI) { if (wr == 0) PG8_BAR; }
    PG8_BAR;
    if constexpr (Epi::AFTER_DRAIN) { E.fused(acc, cur, wr, wc, fr, fq, lds, wid, lane); S.done(cur); }
#undef PG8_SA
#undef PG8_SB
#undef PG8_STAGE
#undef PG8_LDA
#undef PG8_LDB
#undef PG8_MMA
#undef PG8_WAIT_V
#undef PG8_WAIT_L
#undef PG8_BAR
#undef PG8_SCHED
}
}

namespace att {
typedef unsigned short bf16;
typedef short bf16x8 __attribute__((ext_vector_type(8)));
typedef short s16x4 __attribute__((ext_vector_type(4)));
typedef float f32x16 __attribute__((ext_vector_type(16)));
typedef float f32x4 __attribute__((ext_vector_type(4)));
typedef unsigned u32x4 __attribute__((ext_vector_type(4)));
constexpr int NW = 8, QBLK = 32, KVBLK = 64, QB = NW * QBLK, D = 128, PITCH = 6144, OPITCH = 2048, NQB = 8192 / QB;
constexpr int SHM_V = KVBLK * D * 2, SHM_K = KVBLK * D * 2;
constexpr int OFF_WS = 2 * SHM_V + 2 * SHM_K, OFF_BIAS = OFF_WS + NW * 64 * 4, OFF_FLAG = OFF_BIAS + 512, LDS_BYTES = OFF_FLAG + 128;
constexpr float THR2 = 8.f;
#define KSWZ(row, colB) ((row) * 256 + ((colB) ^ (((row) & 7) << 4)))
#define SBAR() __builtin_amdgcn_sched_barrier(0)
__device__ __forceinline__ int v_st(int k, int c) { const int kk = (k & ~0xC) | ((k & 4) << 1) | ((k & 8) >> 1); return ((kk >> 3) * 4 + (c >> 5)) * 512 + ((kk & 7) * 32 + (c & 31)) * 2; }
__device__ __forceinline__ int v_rd_base(int lane) { return ((lane & 3) << 3) | (((lane >> 2) & 3) << 6) | (((lane >> 4) & 1) << 5) | (((lane >> 5) & 1) << 8); }
constexpr int v_rd_off(int d0, int ks, int half) { return d0 * 512 + ks * 4096 + half * 2048; }
__device__ __forceinline__ int crow(int r, int hi) { return (r & 3) + 8 * (r >> 2) + 4 * hi; }
__device__ __forceinline__ unsigned cvtpk(float lo, float hi) { unsigned r; asm volatile("v_cvt_pk_bf16_f32 %0, %1, %2" : "=v"(r) : "v"(lo), "v"(hi)); return r; }
template <int MLIM> __device__ __forceinline__ void mask_tile(f32x16& p0, f32x16& p1, int dq) {
    const float NEG = -__builtin_inff();
#pragma unroll
    for (int r = 0; r < 16; ++r) { const int c = (r & 3) + 8 * (r >> 2);
        if (dq - c < MLIM) p0[r] = NEG;
        if (dq - c - 32 < MLIM) p1[r] = NEG; }
}
__device__ __forceinline__ void partialSM(f32x16& p0, f32x16& p1, float& m_reg, float& alpha) {
    float pmax = p0[0];
#pragma unroll
    for (int r = 1; r < 16; ++r) pmax = fmaxf(pmax, p0[r]);
#pragma unroll
    for (int r = 0; r < 16; ++r) pmax = fmaxf(pmax, p1[r]);
    { auto rr = __builtin_amdgcn_permlane32_swap(__float_as_uint(pmax), __float_as_uint(pmax), false, false);
      pmax = fmaxf(__uint_as_float(rr[0]), __uint_as_float(rr[1])); }
    float mn;
    if (__builtin_expect(__all((pmax - m_reg) <= THR2), 1)) { mn = m_reg; alpha = 1.f; }
    else { mn = fmaxf(m_reg, pmax); alpha = __builtin_amdgcn_exp2f(m_reg - mn); m_reg = mn; }
#pragma unroll
    for (int r = 0; r < 16; ++r) { p0[r] -= mn; p1[r] -= mn; }
#pragma unroll
    for (int r = 0; r < 16; ++r) p0[r] = __builtin_amdgcn_exp2f(p0[r]);
}
#define ATT_PK4(P, B_, OUT) do { unsigned a0 = cvtpk(P[B_+0], P[B_+1]), a1 = cvtpk(P[B_+2], P[B_+3]);                          \
        unsigned b0 = cvtpk(P[B_+4], P[B_+5]), b1 = cvtpk(P[B_+6], P[B_+7]);                                             \
        auto r0 = __builtin_amdgcn_permlane32_swap(a0, b0, false, false); auto r1 = __builtin_amdgcn_permlane32_swap(a1, b1, false, false); \
        u32x4 w = {r0[0], r1[0], r0[1], r1[1]}; OUT = *reinterpret_cast<bf16x8*>(&w); } while (0)
__device__ __forceinline__ void finishSM(f32x16& p0, f32x16& p1, float alpha, float& l_reg, bf16x8& pa0, bf16x8& pa1, bf16x8& pa2, bf16x8& pa3) {
#pragma unroll
    for (int r = 0; r < 16; ++r) p1[r] = __builtin_amdgcn_exp2f(p1[r]);
    float ps = 0;
#pragma unroll
    for (int r = 0; r < 16; ++r) ps += p0[r];
#pragma unroll
    for (int r = 0; r < 16; ++r) ps += p1[r];
    { auto rr = __builtin_amdgcn_permlane32_swap(__float_as_uint(ps), __float_as_uint(ps), false, false);
      ps = __uint_as_float(rr[0]) + __uint_as_float(rr[1]); }
    l_reg = l_reg * alpha + ps;
    ATT_PK4(p0, 0, pa0); ATT_PK4(p0, 8, pa1); ATT_PK4(p1, 0, pa2); ATT_PK4(p1, 8, pa3);
}
__device__ __forceinline__ void sb_partial(f32x16& p0, f32x16& p1, float& R, int dq, bool needmask, int hi) {
    float G[8];
#pragma unroll
    for (int j = 0; j < 8; ++j) { float lom[4];
#pragma unroll
        for (int e = 0; e < 4; ++e) { const int r = 4 * (j & 3) + e; const float z = (j < 4) ? p0[r] : p1[r];
            const float ex = __builtin_amdgcn_exp2f(-__builtin_fabsf(z)); const float lg = __builtin_amdgcn_logf(1.0f + ex);
            float ls = fminf(z, 0.f) - lg; float lo = ls - z;
            if (needmask) { const int c = e + 8 * (j & 3) + ((j < 4) ? 0 : 32); if (dq - c < 1) { lo = 0.f; ls = -__builtin_inff(); } }
            lom[e] = lo; if (j < 4) p0[r] = ls; else p1[r] = ls; }
        const float w2 = lom[3], w1 = w2 + lom[2], w0 = w1 + lom[1]; G[j] = w0 + lom[0];
        const int rb = 4 * (j & 3);
        if (j < 4) { p0[rb + 2] += w2; p0[rb + 1] += w1; p0[rb + 0] += w0; } else { p1[rb + 2] += w2; p1[rb + 1] += w1; p1[rb + 0] += w0; }
    }
    float S = R;
#pragma unroll
    for (int j = 7; j >= 0; --j) { auto rr = __builtin_amdgcn_permlane32_swap(__float_as_uint(G[j]), __float_as_uint(G[j]), false, false);
        const float Pn = hi ? __uint_as_float(rr[0]) : __uint_as_float(rr[1]);
        const float above = S + (hi ? 0.f : Pn);
        const int rb = 4 * (j & 3);
#pragma unroll
        for (int e = 0; e < 4; ++e) { if (j < 4) p0[rb + e] += above; else p1[rb + e] += above; }
        S += (hi ? (Pn + G[j]) : (G[j] + Pn)); }
    R = S;
}
__device__ __forceinline__ void sb_finish(f32x16& p0, f32x16& p1, bf16x8& pa0, bf16x8& pa1, bf16x8& pa2, bf16x8& pa3) {
#pragma unroll
    for (int r = 0; r < 16; ++r) { p0[r] = __builtin_amdgcn_exp2f(p0[r]); p1[r] = __builtin_amdgcn_exp2f(p1[r]); }
    ATT_PK4(p0, 0, pa0); ATT_PK4(p0, 8, pa1); ATT_PK4(p1, 0, pa2); ATT_PK4(p1, 8, pa3);
}
template <int KB, int KIND>
__device__ __forceinline__ void qkt(f32x16& p0, f32x16& p1, const char* K_lds, const char* B_lds, int r32, int hi, const bf16x8* qr) {
    if (KIND == 0) { const char* bb = B_lds + KB * 256 + hi * 16;
#pragma unroll
        for (int i = 0; i < 4; ++i) { const f32x4 b0 = *reinterpret_cast<const f32x4*>(bb + i * 32), b1 = *reinterpret_cast<const f32x4*>(bb + 128 + i * 32);
#pragma unroll
            for (int e = 0; e < 4; ++e) { p0[4 * i + e] = b0[e]; p1[4 * i + e] = b1[e]; } } }
    else { p0 = f32x16{}; p1 = f32x16{}; }
    const char* kb[4];
#pragma unroll
    for (int dd = 0; dd < 4; ++dd) kb[dd] = K_lds + KB * SHM_K + KSWZ(r32, (dd * 16 + hi * 8) * 2);
#pragma unroll
    for (int d0 = 0; d0 < 8; ++d0) { const char* a = kb[d0 & 3] + (d0 >> 2) * 128;
        bf16x8 b0 = *reinterpret_cast<const bf16x8*>(a);
        bf16x8 b1 = *reinterpret_cast<const bf16x8*>(a + 32 * 256);
        p0 = __builtin_amdgcn_mfma_f32_32x32x16_bf16(b0, qr[d0], p0, 0, 0, 0);
        p1 = __builtin_amdgcn_mfma_f32_32x32x16_bf16(b1, qr[d0], p1, 0, 0, 0); }
}
template <int VB>
__device__ __forceinline__ void pv_tile(f32x16* o, int vb0, bf16x8 pa0, bf16x8 pa1, bf16x8 pa2, bf16x8 pa3) {
#define TRRD(dst, off) asm volatile("ds_read_b64_tr_b16 %0, %1 offset:%2" : "=&v"(dst) : "v"(vb0), "i"(off) : "memory")
#define PV_D0(d0) do { s16x4 l0, l1, l2, l3, h0, h1, h2, h3; constexpr int b_ = VB * SHM_V + v_rd_off(d0, 0, 0); \
        TRRD(l0, b_); TRRD(h0, b_ + 2048); TRRD(l1, b_ + 4096); TRRD(h1, b_ + 6144); TRRD(l2, b_ + 8192); TRRD(h2, b_ + 10240); TRRD(l3, b_ + 12288); TRRD(h3, b_ + 14336); \
        asm volatile("s_waitcnt lgkmcnt(0)" ::: "memory"); SBAR();   \
        o[d0] = __builtin_amdgcn_mfma_f32_32x32x16_bf16(pa0, (bf16x8){l0[0], l0[1], l0[2], l0[3], h0[0], h0[1], h0[2], h0[3]}, o[d0], 0, 0, 0);   \
        o[d0] = __builtin_amdgcn_mfma_f32_32x32x16_bf16(pa1, (bf16x8){l1[0], l1[1], l1[2], l1[3], h1[0], h1[1], h1[2], h1[3]}, o[d0], 0, 0, 0);   \
        o[d0] = __builtin_amdgcn_mfma_f32_32x32x16_bf16(pa2, (bf16x8){l2[0], l2[1], l2[2], l2[3], h2[0], h2[1], h2[2], h2[3]}, o[d0], 0, 0, 0);   \
        o[d0] = __builtin_amdgcn_mfma_f32_32x32x16_bf16(pa3, (bf16x8){l3[0], l3[1], l3[2], l3[3], h3[0], h3[1], h3[2], h3[3]}, o[d0], 0, 0, 0); } while (0)
    PV_D0(0); PV_D0(1); PV_D0(2); PV_D0(3);
#undef PV_D0
#undef TRRD
}
struct BlockRef { const bf16* Q; const bf16* K; const bf16* V; bf16* O; const float* CB; int P0; };
struct Seam { bf16x8 qr[8]; bf16x8 st_v0, st_v1, st_k0, st_k1; f32x4 st_b; };
template <int KIND> __device__ __forceinline__ int first_kb(int P0) { return KIND == 2 ? P0 + QB - KVBLK : 0; }
#define AROW(p, k0, rr) ((p) + (size_t)((k0) + (rr)) * PITCH + sc)
#define VMW() asm volatile("s_waitcnt vmcnt(0)" ::: "memory")
#define VMWN(n) asm volatile("s_waitcnt vmcnt(%0)" :: "i"(n) : "memory")
#define LD8(p) (*reinterpret_cast<const bf16x8*>(p))
#define SLOAD_B(R_, k0) do { if (KIND == 0 && tid < 16) { const f32x4 t_ = *(const f32x4*)((R_).CB + (k0) + 4 * tid); const float cr_ = (R_).CB[(R_).P0]; S.st_b = t_ - cr_; } } while (0)
#define SLOAD_H(R_, k0) do { S.st_v0 = LD8(AROW((R_).V, k0, sr)); S.st_v1 = LD8(AROW((R_).V, k0, 32 + sr)); S.st_k0 = LD8(AROW((R_).K, k0, sr)); S.st_k1 = LD8(AROW((R_).K, k0, 32 + sr)); SLOAD_B(R_, k0); } while (0)
#define SWRITE_HK(bf) do { *(bf16x8*)(K_lds + (bf) * SHM_K + kws) = S.st_k0; *(bf16x8*)(K_lds + (bf) * SHM_K + kws + 32 * 256) = S.st_k1; \
                           if (KIND == 0 && tid < 16) *(f32x4*)(B_lds + (bf) * 256 + tid * 16) = S.st_b; } while (0)
#define SWRITE_HV(bf) do { *(bf16x8*)(V_lds + (bf) * SHM_V + vst0) = S.st_v0; *(bf16x8*)(V_lds + (bf) * SHM_V + vst1) = S.st_v1; } while (0)
#define SWRITE_H(bf) do { SWRITE_HV(bf); SWRITE_HK(bf); } while (0)
template <int KIND>
__device__ __forceinline__ void attn_prime(const BlockRef& cur, char* lds, Seam& S, const int tid) {
    const int wid = __builtin_amdgcn_readfirstlane(tid >> 6), lane = tid & 63, r32 = lane & 31, hi = lane >> 5;
    const int sr = tid >> 4, sc = (tid & 15) * 8, kws = KSWZ(sr, sc * 2); char* K_lds = lds + 2 * SHM_V; char* B_lds = lds + OFF_BIAS;
    const int kb0 = first_kb<KIND>(cur.P0);
#pragma unroll
    for (int d0 = 0; d0 < 8; ++d0) S.qr[d0] = LD8(cur.Q + (size_t)(wid * QBLK + r32) * PITCH + d0 * 16 + hi * 8);
    SLOAD_H(cur, kb0); VMW(); SWRITE_HK(0);
    __syncthreads();
}
template <int KIND>
__device__ __forceinline__ void attn_block(const BlockRef& cur, const BlockRef& nxt, char* lds, Seam& S, const int tid) {
    constexpr int MLIM = (KIND == 2) ? 1 : 0;
    const int wid = __builtin_amdgcn_readfirstlane(tid >> 6), lane = tid & 63, r32 = lane & 31, hi = lane >> 5;
    const int NT = cur.P0 / KVBLK + QB / KVBLK;
    const int kbn = first_kb<KIND>(nxt.P0);
    const int qlo = cur.P0 + wid * QBLK, qm = qlo + r32 - 4 * hi;
    char* V_lds = lds; char* K_lds = lds + 2 * SHM_V; char* B_lds = lds + OFF_BIAS;
    float* ws = (float*)(lds + OFF_WS) + wid * 64; float* li_l = ws, * al_l = ws + 32;
    float m_reg = -1e30f, l_reg = 0.f, R = 0.f; f32x16 o[4] = {};
    const int sr = tid >> 4, sc = (tid & 15) * 8, vst0 = v_st(sr, sc), vst1 = v_st(32 + sr, sc), kws = KSWZ(sr, sc * 2);
    const int vb0 = (int)(uintptr_t)V_lds + v_rd_base(lane);
#define RESC(a) do { if (KIND == 0) { if (__any((a) < 1.f)) { if (hi == 0) al_l[r32] = (a); asm volatile("s_waitcnt lgkmcnt(0)" ::: "memory");              \
                     for (int d_ = 0; d_ < 4; ++d_) for (int r = 0; r < 16; ++r) o[d_][r] *= al_l[crow(r, hi)]; } } } while (0)
#define KBASE(t) ((KIND == 2 ? (NT - 1 - (t)) : (t)) * KVBLK)
#define NEEDM(kb_) ((kb_) + KVBLK - 1 + MLIM > qlo)
#define SM1(PX0, PX1, alX, t) do { const int kb_ = KBASE(t); if (KIND == 0) { if (NEEDM(kb_)) mask_tile<0>(PX0, PX1, qm - kb_); partialSM(PX0, PX1, m_reg, alX); } \
                                   else { sb_partial(PX0, PX1, R, qm - kb_, NEEDM(kb_), hi); } } while (0)
#define SM2(PY0, PY1, alY) do { if (KIND == 0) finishSM(PY0, PY1, alY, l_reg, pa0, pa1, pa2, pa3); else sb_finish(PY0, PY1, pa0, pa1, pa2, pa3); } while (0)
    constexpr int NQL = 8;
#define SEAM_K0() do { VMWN(NQL); SWRITE_HK(0); SBAR(); } while (0)
    f32x16 pA0, pA1, pB0, pB1; float alA = 1.f, alB = 1.f; bf16x8 pa0, pa1, pa2, pa3;
    SWRITE_HV(0); SBAR();
    if (NT > 1) SLOAD_H(cur, KBASE(1));
    SBAR(); qkt<0, KIND>(pA0, pA1, K_lds, B_lds, r32, hi, S.qr);
    SM1(pA0, pA1, alA, 0);
    if (NT > 1) { VMW(); SWRITE_H(1); }
    __syncthreads();
#define HALF_STEP(PX0, PX1, alX, PY0, PY1, alY, t, KB, VB, SB) do {                                                      \
        SBAR(); qkt<KB, KIND>(PX0, PX1, K_lds, B_lds, r32, hi, S.qr);                                             \
        SM2(PY0, PY1, alY); SBAR();                                                           \
        if ((t) + 1 < NT) { SLOAD_H(cur, KBASE((t) + 1)); SBAR(); }                                               \
        pv_tile<VB>(o, vb0, pa0, pa1, pa2, pa3); SM1(PX0, PX1, alX, (t));                                        \
        __syncthreads();                                                                                                      \
        if ((t) + 1 < NT) { VMW(); SWRITE_H(SB); }                                                                          \
        RESC(alX); __syncthreads(); } while (0)
    for (int t = 1; t + 1 < NT; t += 2) {
        HALF_STEP(pB0, pB1, alB, pA0, pA1, alA, t, 1, 0, 0);
        HALF_STEP(pA0, pA1, alA, pB0, pB1, alB, t + 1, 0, 1, 1);
    }
    SBAR(); qkt<1, KIND>(pB0, pB1, K_lds, B_lds, r32, hi, S.qr); SBAR();
    SLOAD_H(nxt, kbn); SBAR();
#pragma unroll
    for (int d0 = 0; d0 < 8; ++d0) S.qr[d0] = LD8(nxt.Q + (size_t)(wid * QBLK + r32) * PITCH + d0 * 16 + hi * 8);
    SBAR();
    SM2(pA0, pA1, alA); SBAR();
    pv_tile<0>(o, vb0, pa0, pa1, pa2, pa3);
    SM1(pB0, pB1, alB, NT - 1); __syncthreads(); RESC(alB);
    SM2(pB0, pB1, alB); SBAR(); pv_tile<1>(o, vb0, pa0, pa1, pa2, pa3);
    SBAR(); SEAM_K0();
    float rli[16];
    if (KIND == 0) { if (hi == 0) li_l[r32] = l_reg; asm volatile("s_waitcnt lgkmcnt(0)" ::: "memory");
#pragma unroll
        for (int r = 0; r < 16; ++r) rli[r] = __builtin_amdgcn_rcpf(li_l[crow(r, hi)]); }
    else {
#pragma unroll
        for (int r = 0; r < 16; ++r) rli[r] = 1.f; }
    bf16* Ow = cur.O + (size_t)(wid * QBLK) * OPITCH;
#pragma unroll
    for (int r = 0; r < 16; ++r) { const int orow = crow(r, hi);
#pragma unroll
        for (int d0 = 0; d0 < 4; ++d0) { const float v = o[d0][r] * rli[r]; const float vn = __shfl_xor(v, 1);
            if ((r32 & 1) == 0) *(unsigned*)(Ow + (size_t)orow * OPITCH + d0 * 32 + r32) = cvtpk(v, vn); } }
    __syncthreads();
#undef RESC
#undef KBASE
#undef NEEDM
#undef SM1
#undef SM2
#undef SEAM_K0
#undef HALF_STEP
}
#undef AROW
#undef VMW
#undef VMWN
#undef LD8
#undef SLOAD_B
#undef SLOAD_H
#undef SWRITE_HK
#undef SWRITE_HV
#undef SWRITE_H
template <int KIND>
__device__ __forceinline__ void attn_phase(char* lds, const bf16* QKV, bf16* OB, const float* CNEG) {
    const int total = 16 * (NQB / 2), stride = gridDim.x;
    int L = blockIdx.x; if (L >= total) return;
    int pass = 0;
#define ITEM_REF(L_, pass_, ref) do { const int xcd_ = (L_) & 7, k_ = (L_) >> 3, h_ = xcd_ * 2 + (k_ >> 4), x_ = k_ & 15, qb_ = (pass_) ? (NQB - 1 - x_) : x_; \
        ref.Q = QKV + (size_t)qb_ * QB * PITCH + h_ * D; ref.K = QKV + 2048 + h_ * D; ref.V = QKV + 4096 + h_ * D; ref.O = OB + (size_t)qb_ * QB * OPITCH + h_ * D; \
        ref.CB = CNEG + (size_t)h_ * 8192; ref.P0 = qb_ * QB; } while (0)
    BlockRef cur; ITEM_REF(L, 0, cur);
    Seam S; S.st_b = f32x4{0.f, 0.f, 0.f, 0.f};
    int tid = threadIdx.x; asm volatile("" : "+v"(tid));
    attn_prime<KIND>(cur, lds, S, tid);
    for (;;) {
        const bool more_pass = pass == 0, more_item = L + stride < total, last = !more_pass && !more_item;
        int passn = pass + 1, Ln = L;
        if (!more_pass) { passn = 0; Ln = more_item ? L + stride : L; }
        BlockRef nxt; if (last) nxt = cur; else ITEM_REF(Ln, passn, nxt);
        attn_block<KIND>(cur, nxt, lds, S, tid);
        if (last) break;
        cur = nxt; pass = passn; L = Ln;
    }
#undef ITEM_REF
}
#undef KSWZ
#undef SBAR
#undef ATT_PK4
}

constexpr int NWAVES = 8;
constexpr int SEQ = 8192, DM = 2048, FF = 5632, NH = 16, HD = 128, DEPTH = 4, NQKV = 3 * DM, FOXN = 3 * DM + NH;
constexpr float LOG2E = 1.4426950408889634f;
constexpr float QSCALE = 0.08838834764831845f * LOG2E;
constexpr float EPS = 1e-6f;
constexpr size_t MiB = 1u << 20;
constexpr size_t WS_CTL = 0, CTL_ZERO_BYTES = 2 * MiB;
constexpr size_t WS_SS = 1 * MiB;
constexpr size_t WS_CNEG = 2 * MiB;
constexpr size_t WS_LOGF = 3 * MiB;
constexpr size_t WS_XB = 4 * MiB;
constexpr size_t WS_QKV = 36 * MiB;
constexpr size_t WS_OB = 132 * MiB;
constexpr size_t WS_ACT = 164 * MiB;
constexpr size_t WS_W = 256 * MiB, W_LAYER = 164 * MiB;
constexpr size_t W_GU0 = 0, W_D0 = 44 * MiB, W_GU1 = 66 * MiB, W_D1 = 110 * MiB, W_IN = 132 * MiB, W_OUT = 156 * MiB;
constexpr size_t WS_END = WS_W + DEPTH * W_LAYER;
constexpr int CW_BAR = 4096;
constexpr int RING_BYTES = 131072, LDSCTL_OFF = RING_BYTES, MISC_OFF = LDSCTL_OFF + 320, LDS_BYTES = 147456;
constexpr int N_PHASES = 31;

#define GAS __attribute__((address_space(1)))
#define LAS __attribute__((address_space(3)))
typedef unsigned short bf16;
typedef unsigned v4u __attribute__((ext_vector_type(4)));
typedef unsigned v2u __attribute__((ext_vector_type(2)));
typedef float f32x4 __attribute__((ext_vector_type(4)));
#define LDS_WAIT() asm volatile("s_waitcnt lgkmcnt(0)" ::: "memory")
#define VM_WAIT() asm volatile("s_waitcnt vmcnt(0)" ::: "memory")
__device__ __forceinline__ unsigned f2bf(float f) { unsigned u = __builtin_bit_cast(unsigned, f); return (u + 0x7fffu + ((u >> 16) & 1u)) >> 16; }
__device__ __forceinline__ unsigned pk2(float lo, float hi) { return f2bf(lo) | (f2bf(hi) << 16); }
__device__ __forceinline__ float bf_lo(unsigned w) { return __uint_as_float(w << 16); }
__device__ __forceinline__ float bf_hi(unsigned w) { return __uint_as_float(w & 0xffff0000u); }

#define XB_TMO      128
#define XB_XCNT(j)  (256  + 64 * (j))
#define XB_XSUB(j)  (1280 + 64 * (j))
#define XB_XGEN(j)  (2304 + 64 * (j))
#define XB_TOP      3328
#define XB_TOPGEN   3392
#define XCD_BAR_WORDS 3456
#define XB_SPIN_CAP (1u << 18)

__device__ __forceinline__ unsigned xb_ld(unsigned* p)              { return __hip_atomic_load(p, __ATOMIC_RELAXED, __HIP_MEMORY_SCOPE_AGENT); }
__device__ __forceinline__ unsigned xb_add(unsigned* p, unsigned v) { return __hip_atomic_fetch_add(p, v, __ATOMIC_RELAXED, __HIP_MEMORY_SCOPE_AGENT); }
__device__ __forceinline__ unsigned xb_xcc_id() { return (unsigned)__builtin_amdgcn_s_getreg((3 << 11) | 20) & 0xFu; }
#define XB_SPIN(cond, bar) do { unsigned _sp = 0; while (cond) { __builtin_amdgcn_s_sleep(1); \
    if ((++_sp & 255u) == 0u) { if (xb_ld(&(bar)[XB_TMO])) break; if (_sp > XB_SPIN_CAP) { atomicAdd(&(bar)[XB_TMO], 1u); break; } } } } while (0)

struct XcdBarrier {
    unsigned* bar; unsigned x;
    volatile LAS unsigned* st;
};

__device__ __forceinline__ XcdBarrier xcd_barrier_post(unsigned* bar, volatile LAS unsigned* st) {
    XcdBarrier b; b.bar = bar; b.x = xb_xcc_id(); b.st = st;
    if (threadIdx.x == 0) (void)xb_add(&bar[XB_XCNT(b.x)], 1u);
    return b;
}
__device__ __forceinline__ void xcd_barrier_complete(unsigned* bar, unsigned x, unsigned& nloc, unsigned& nx) {
    const unsigned G = gridDim.x * gridDim.y * gridDim.z;
    unsigned sum, cnt, mine, sp = 0u;
    for (;;) {
        sum = 0u; cnt = 0u; mine = 0u;
#pragma unroll
        for (unsigned j = 0; j < 16; ++j) { const unsigned c = xb_ld(&bar[XB_XCNT(j)]); sum += c; cnt += (c > 0u) ? 1u : 0u; mine = (j == x) ? c : mine; }
        if (sum == G) break;
        __builtin_amdgcn_s_sleep(1);
        if ((++sp & 255u) == 0u) { if (xb_ld(&bar[XB_TMO])) break; if (sp > XB_SPIN_CAP) { atomicAdd(&bar[XB_TMO], 1u); break; } }
    }
    nloc = mine > 0u ? mine : 1u; nx = cnt > 0u ? cnt : 1u;
}

__device__ __forceinline__ void xcd_barrier(const XcdBarrier& b) {
    asm volatile("s_waitcnt vmcnt(0)" ::: "memory");
    __syncthreads();
    if (threadIdx.x == 0) {
        unsigned* bar = b.bar;
        __builtin_amdgcn_s_waitcnt(0);
        unsigned nloc = b.st[0], nx = b.st[1];
        if (nloc == 0u) { xcd_barrier_complete(bar, b.x, nloc, nx); b.st[0] = nloc; b.st[1] = nx; }
        const unsigned old = xb_add(&bar[XB_XSUB(b.x)], 1u);
        const unsigned gen = old / nloc;
        if (old + 1u == (gen + 1u) * nloc) {
            __builtin_amdgcn_fence(__ATOMIC_RELEASE, "agent");
            asm volatile("s_waitcnt vmcnt(0)" ::: "memory");
            const unsigned og = xb_add(&bar[XB_TOP], 1u);
            const unsigned tg = og / nx;
            if (og + 1u == (tg + 1u) * nx) xb_add(&bar[XB_TOPGEN], 1u);
            else XB_SPIN(xb_ld(&bar[XB_TOPGEN]) == tg, bar);
            __builtin_amdgcn_fence(__ATOMIC_ACQUIRE, "agent");
            xb_add(&bar[XB_XGEN(b.x)], 1u);
            asm volatile("s_waitcnt vmcnt(0)" ::: "memory");
        } else {
            XB_SPIN(xb_ld(&bar[XB_XGEN(b.x)]) == gen, bar);
            __builtin_amdgcn_fence(__ATOMIC_ACQUIRE, "agent");
            asm volatile("s_waitcnt vmcnt(0)" ::: "memory");
        }
    }
    __syncthreads();
}

struct Frame {
    LAS unsigned char* lds;
    int wave, gw, ngw;
    float* X;
    unsigned char* ws;
};
typedef const __attribute__((address_space(4))) char* kptr_t;
__device__ __forceinline__ const float* in_ptr(int k) {
    kptr_t kp = (kptr_t)__builtin_amdgcn_kernarg_segment_ptr(); asm volatile("" : "+s"(kp));
    return *(const float* const __attribute__((address_space(4)))*)(kp + 8 * k);
}
#define WSP(T, off) ((T*)(F.ws + (off)))
__device__ __forceinline__ int fresh_tid() { int t = threadIdx.x; asm volatile("" : "+v"(t)); return t; }
__device__ __forceinline__ float wave_sum(float v) {
#pragma unroll
    for (int o = 1; o < 64; o <<= 1) v += __shfl_xor(v, o);
    return v;
}
__device__ __forceinline__ float wave_max(float v) {
#pragma unroll
    for (int o = 1; o < 64; o <<= 1) v = fmaxf(v, __shfl_xor(v, o));
    return v;
}
__device__ __forceinline__ void tr_item(const float* W, size_t ldw, const float* gain, int K, bf16* WT, int dst_row0, int k0, int n0, LAS float* scr, int lane) {
#pragma unroll 8
    for (int i = 0; i < 32; ++i) { const int kk = 2 * i + (lane >> 5); const float g = gain ? gain[k0 + kk] : 1.0f;
        scr[kk * 33 + (lane & 31)] = W[(size_t)(k0 + kk) * ldw + n0 + (lane & 31)] * g; }
    LDS_WAIT(); asm volatile("" ::: "memory");
    const int c = lane & 7;
#pragma unroll
    for (int j = 0; j < 4; ++j) { const int n = (lane >> 3) + 8 * j; const LAS float* s = scr + (8 * c) * 33 + n;
        v4u o; o.x = pk2(s[0 * 33], s[1 * 33]); o.y = pk2(s[2 * 33], s[3 * 33]); o.z = pk2(s[4 * 33], s[5 * 33]); o.w = pk2(s[6 * 33], s[7 * 33]);
        *(GAS v4u*)(WT + (size_t)(dst_row0 + n) * K + k0 + 8 * c) = o; }
    LDS_WAIT(); asm volatile("" ::: "memory");
}
#define ROW_ID(n0) (n0)
#define ROW_GATE(n0) ((((n0) >> 7) << 8) + ((n0) & 127))
#define ROW_UP(n0) ((((n0) >> 7) << 8) + ((n0) & 127) + 128)
#define TR_MAT(Wsrc, LDW, NCOLS, GAIN, KK, DST, ROWMAP) do { const int nblk_ = (NCOLS) / 32; const int nitems_ = ((KK) / 64) * nblk_; \
        while (it < base + nitems_) { const int r_ = it - base; const int kb_ = r_ / nblk_, nb_ = r_ % nblk_; const int n0_ = nb_ * 32; \
            tr_item((Wsrc), (size_t)(LDW), (GAIN), (KK), (DST), ROWMAP(n0_), kb_ * 64, n0_, scr, lane); it += F.ngw; } base += nitems_; } while (0)
__device__ __forceinline__ void p_prologue(Frame& F) {
    const int lane = fresh_tid() & 63;
    LAS float* scr = (LAS float*)(F.lds + F.wave * 16384);
    int it = F.gw, base = 0;
    for (int l = 0; l < DEPTH; ++l) {
        unsigned char* wl = F.ws + WS_W + (size_t)l * W_LAYER;
        const float* g1 = in_ptr(1) + l * DM; const float* gm = in_ptr(2) + l * DM; const float* g2 = in_ptr(3) + l * DM;
        const size_t offGU = (size_t)l * DM * FF, offD = (size_t)l * FF * DM;
        TR_MAT(in_ptr(4) + offGU, FF, FF, g1, DM, (bf16*)(wl + W_GU0), ROW_GATE);
        TR_MAT(in_ptr(5) + offGU, FF, FF, g1, DM, (bf16*)(wl + W_GU0), ROW_UP);
        TR_MAT(in_ptr(6) + offD, DM, DM, (const float*)nullptr, FF, (bf16*)(wl + W_D0), ROW_ID);
        TR_MAT(in_ptr(7) + offGU, FF, FF, g2, DM, (bf16*)(wl + W_GU1), ROW_GATE);
        TR_MAT(in_ptr(8) + offGU, FF, FF, g2, DM, (bf16*)(wl + W_GU1), ROW_UP);
        TR_MAT(in_ptr(9) + offD, DM, DM, (const float*)nullptr, FF, (bf16*)(wl + W_D1), ROW_ID);
        const int kind = l % 3, j = l / 3;
        const float* win; const float* wout; int ldw;
        if (kind == 0) { win = in_ptr(10) + (size_t)j * DM * FOXN; wout = in_ptr(14) + (size_t)j * DM * DM; ldw = FOXN; }
        else if (kind == 1) { win = in_ptr(15) + (size_t)j * DM * NQKV; wout = in_ptr(17) + (size_t)j * DM * DM; ldw = NQKV; }
        else { win = in_ptr(18) + (size_t)j * DM * NQKV; wout = in_ptr(19) + (size_t)j * DM * DM; ldw = NQKV; }
        TR_MAT(win, ldw, NQKV, gm, DM, (bf16*)(wl + W_IN), ROW_ID);
        TR_MAT(wout, DM, DM, (const float*)nullptr, DM, (bf16*)(wl + W_OUT), ROW_ID);
    }
    const float* xin = in_ptr(0);
    for (int m = F.gw; m < SEQ; m += F.ngw) {
        const GAS f32x4* xr = (const GAS f32x4*)(xin + (size_t)m * DM) + lane; GAS f32x4* xo = (GAS f32x4*)(F.X + (size_t)m * DM) + lane;
        GAS v2u* xb = (GAS v2u*)(WSP(bf16, WS_XB) + (size_t)m * DM) + lane; float s = 0.f;
#pragma unroll
        for (int j = 0; j < 8; ++j) { const f32x4 v = xr[64 * j]; xo[64 * j] = v; s += (v.x * v.x + v.y * v.y) + (v.z * v.z + v.w * v.w);
            v2u w; w.x = pk2(v.x, v.y); w.y = pk2(v.z, v.w); xb[64 * j] = w; }
        s = wave_sum(s);
        if (lane == 0) WSP(pg8::u64_t, WS_SS)[m] = (pg8::u64_t)(s * pg8::SS_FIX);
    }
}
__device__ __forceinline__ void p_fgate(Frame& F, int l, const pg8::u64_t* ss) {
    const int j = l / 3; const float* Wf = in_ptr(10) + (size_t)j * DM * FOXN + NQKV; const float* g = in_ptr(2) + l * DM; const float* bf = in_ptr(11) + j * NH;
    const int lane = fresh_tid() & 63;
    for (int rb = F.gw; rb < SEQ / 2; rb += F.ngw) {
        const int t0 = rb * 2; float acc[2][16];
#pragma unroll
        for (int r = 0; r < 2; ++r)
#pragma unroll
            for (int h = 0; h < 16; ++h) acc[r][h] = 0.f;
#pragma unroll 1
        for (int jj = 0; jj < 8; ++jj) { const int kb = 256 * jj + 4 * lane;
            const f32x4 x0 = *(const f32x4*)(F.X + (size_t)t0 * DM + kb), x1 = *(const f32x4*)(F.X + (size_t)(t0 + 1) * DM + kb);
            const f32x4 gv = *(const f32x4*)(g + kb);
#pragma unroll
            for (int i = 0; i < 4; ++i) { const float* wp = Wf + (size_t)(kb + i) * FOXN; const float xg0 = x0[i] * gv[i], xg1 = x1[i] * gv[i];
#pragma unroll
                for (int q = 0; q < 4; ++q) { const f32x4 w = *(const f32x4*)(wp + 4 * q);
#pragma unroll
                    for (int e = 0; e < 4; ++e) { acc[0][4 * q + e] += xg0 * w[e]; acc[1][4 * q + e] += xg1 * w[e]; } } } }
        float mine = 0.f;
#pragma unroll
        for (int r = 0; r < 2; ++r)
#pragma unroll
            for (int h = 0; h < 16; ++h) { const float s = wave_sum(acc[r][h]); if ((lane & 31) == r * 16 + h) mine = s; }
        if (lane < 32) { const int r = lane >> 4, h = lane & 15;
            const float rs = 1.0f / sqrtf((float)ss[t0 + r] * (pg8::SS_UNFIX / DM) + EPS);
            const float u = mine * rs + bf[h];
            WSP(float, WS_LOGF)[(size_t)(t0 + r) * NH + h] = fminf(u, 0.f) - log1pf(expf(-fabsf(u))); }
    }
}
__device__ __forceinline__ void p_qknorm_cumsum(Frame& F, int l) {
    const int j = l / 3; const float* qg = in_ptr(12) + j * HD; const float* kg = in_ptr(13) + j * HD;
    const int tid = fresh_tid(), lane = tid & 63;
    if (blockIdx.x < NH) {
        const int h = blockIdx.x; LAS float* wtot = (LAS float*)F.lds;
        float v[16]; const int t0 = tid * 16; float run = 0.f;
#pragma unroll
        for (int i = 0; i < 16; ++i) { run += WSP(float, WS_LOGF)[(size_t)(t0 + i) * NH + h]; v[i] = run; }
        float inc = run;
#pragma unroll
        for (int o = 1; o < 64; o <<= 1) { const float tv = __shfl_up(inc, o); if (lane >= o) inc += tv; }
        if (lane == 63) wtot[F.wave] = inc;
        __syncthreads();
        float wbase = 0.f;
        for (int w = 0; w < F.wave; ++w) wbase += wtot[w];
        const float excl = wbase + inc - run;
#pragma unroll
        for (int i = 0; i < 16; ++i) WSP(float, WS_CNEG)[(size_t)h * SEQ + t0 + i] = -(excl + v[i]) * LOG2E;
        __syncthreads();
    }
    const int hd0 = (lane & 3) * 32;
    for (int t = F.gw; t < SEQ; t += F.ngw) {
#pragma unroll
        for (int part = 0; part < 2; ++part) {
            bf16* p = WSP(bf16, WS_QKV) + (size_t)t * NQKV + part * DM + lane * 32; const float* gn = part ? kg : qg; const float post = part ? 1.0f : QSCALE;
            v4u w[4]; float x[32]; float s = 0.f;
#pragma unroll
            for (int c = 0; c < 4; ++c) w[c] = *(const v4u*)(p + 8 * c);
#pragma unroll
            for (int c = 0; c < 4; ++c)
#pragma unroll
                for (int e = 0; e < 4; ++e) { x[8 * c + 2 * e] = bf_lo(w[c][e]); x[8 * c + 2 * e + 1] = bf_hi(w[c][e]); }
#pragma unroll
            for (int i = 0; i < 32; ++i) s += x[i] * x[i];
            s += __shfl_xor(s, 1); s += __shfl_xor(s, 2);
            const float rs = post / sqrtf(s * (1.0f / HD) + EPS);
#pragma unroll
            for (int c = 0; c < 4; ++c) { v4u o;
#pragma unroll
                for (int e = 0; e < 4; ++e) o[e] = pk2(x[8 * c + 2 * e] * rs * gn[hd0 + 8 * c + 2 * e], x[8 * c + 2 * e + 1] * rs * gn[hd0 + 8 * c + 2 * e + 1]);
                *(v4u*)(p + 8 * c) = o; }
        }
    }
}
__device__ __forceinline__ void p_conv(Frame& F, int l) {
    const float* ck = in_ptr(16) + (size_t)(l / 3) * 3 * DM; const int lane = fresh_tid() & 63;
    const int nthr = F.ngw * 64;
    for (int idx = F.gw * 64 + lane; idx < SEQ * (DM / 8); idx += nthr) {
        const int t = idx >> 8, c = (idx & 255) * 8;
        float in0[8], in1[8], in2[8];
#pragma unroll
        for (int d = 0; d < 3; ++d) { float* dst = d == 0 ? in0 : (d == 1 ? in1 : in2);
            if (t - d >= 0) { const bf16* r = WSP(bf16, WS_QKV) + (size_t)(t - d) * NQKV + c; const v4u cg = *(const v4u*)(r + DM), uu = *(const v4u*)(r + 2 * DM);
#pragma unroll
                for (int e = 0; e < 4; ++e) { dst[2 * e] = bf_lo(cg[e]) * bf_lo(uu[e]); dst[2 * e + 1] = bf_hi(cg[e]) * bf_hi(uu[e]); } }
            else {
#pragma unroll
                for (int e = 0; e < 8; ++e) dst[e] = 0.f; } }
        const v4u bg = *(const v4u*)(WSP(bf16, WS_QKV) + (size_t)t * NQKV + c); float y[8];
#pragma unroll
        for (int e = 0; e < 8; ++e) { const float cv = ck[c + e] * in2[e] + ck[DM + c + e] * in1[e] + ck[2 * DM + c + e] * in0[e];
            const float b = (e & 1) ? bf_hi(bg[e >> 1]) : bf_lo(bg[e >> 1]); y[e] = b * cv; }
        v4u o; o.x = pk2(y[0], y[1]); o.y = pk2(y[2], y[3]); o.z = pk2(y[4], y[5]); o.w = pk2(y[6], y[7]);
        *(v4u*)(WSP(bf16, WS_OB) + (size_t)t * DM + c) = o;
    }
}
template <int KIND>
__device__ __forceinline__ void p_attn_naive(Frame& F) {
    const int lane = fresh_tid() & 63;
    for (int p = F.gw; p < SEQ * NH; p += F.ngw) {
        const int h = p & 15, t = p >> 4;
        const bf16* Qr = WSP(bf16, WS_QKV) + (size_t)t * NQKV + h * HD; const bf16* Kh = WSP(bf16, WS_QKV) + DM + h * HD; const bf16* Vh = WSP(bf16, WS_QKV) + 2 * DM + h * HD + 2 * lane;
        LAS float* q = (LAS float*)(F.lds + F.wave * 1024);
        { const unsigned w = *(const unsigned*)(Qr + 2 * lane); asm volatile("" ::: "memory"); q[2 * lane] = bf_lo(w); q[2 * lane + 1] = bf_hi(w); LDS_WAIT(); asm volatile("" ::: "memory"); }
        float o0 = 0.f, o1 = 0.f;
        if (KIND == 0) {
            const float* cn = WSP(float, WS_CNEG) + (size_t)h * SEQ; const float cnt = cn[t];
            float m = -1e30f, lsum = 0.f; const int nt = t / 64 + 1;
            for (int jt = 0; jt < nt; ++jt) { asm volatile("" ::: "memory"); const int s0 = jt * 64, s = s0 + lane; const bf16* kr = Kh + (size_t)s * NQKV; float dot = 0.f;
#pragma unroll
                for (int c = 0; c < 16; ++c) { const v4u w = *(const v4u*)(kr + 8 * c);
#pragma unroll
                    for (int e = 0; e < 4; ++e) dot += q[8 * c + 2 * e] * bf_lo(w[e]) + q[8 * c + 2 * e + 1] * bf_hi(w[e]); }
                float sc = dot + (cn[s] - cnt); if (s > t) sc = -__builtin_inff();
                const float mn = fmaxf(m, wave_max(sc)); const float pr = exp2f(sc - mn), al = exp2f(m - mn);
                lsum = lsum * al + wave_sum(pr); o0 *= al; o1 *= al; m = mn;
#pragma unroll 8
                for (int jj = 0; jj < 64; ++jj) { const float pj = __int_as_float(__builtin_amdgcn_readlane(__float_as_int(pr), jj));
                    const unsigned vv = *(const unsigned*)(Vh + (size_t)(s0 + jj) * NQKV); o0 += pj * bf_lo(vv); o1 += pj * bf_hi(vv); } }
            const float il = 1.0f / lsum; o0 *= il; o1 *= il;
        } else {
            float R = 0.f;
            for (int jt = (t - 1) >> 6; jt >= 0 && t > 0 && R > -200.f; --jt) {     asm volatile("" ::: "memory"); const int s0 = jt * 64, s = s0 + lane; const bf16* kr = Kh + (size_t)s * NQKV; float z = 0.f;
#pragma unroll
                for (int c = 0; c < 16; ++c) { const v4u w = *(const v4u*)(kr + 8 * c);
#pragma unroll
                    for (int e = 0; e < 4; ++e) z += q[8 * c + 2 * e] * bf_lo(w[e]) + q[8 * c + 2 * e + 1] * bf_hi(w[e]); }
                const bool valid = s < t;
                const float ls = fminf(z, 0.f) - log2f(1.0f + exp2f(-fabsf(z)));
                const float lom = valid ? ls - z : 0.f;
                float inc = lom;
#pragma unroll
                for (int o = 1; o < 64; o <<= 1) { const float tv = __shfl_down(inc, o); if (lane + o < 64) inc += tv; }
                const float a = valid ? exp2f(ls + R + (inc - lom)) : 0.f;
                R += __int_as_float(__builtin_amdgcn_readlane(__float_as_int(inc), 0));
#pragma unroll 8
                for (int jj = 0; jj < 64; ++jj) { const float pj = __int_as_float(__builtin_amdgcn_readlane(__float_as_int(a), jj));
                    const unsigned vv = *(const unsigned*)(Vh + (size_t)(s0 + jj) * NQKV); o0 += pj * bf_lo(vv); o1 += pj * bf_hi(vv); } }
        }
        *(unsigned*)(WSP(bf16, WS_OB) + (size_t)t * DM + h * HD + 2 * lane) = pk2(o0, o1);
    }
}

struct Args { const float* in[20]; float* out; unsigned char* ws; int ph_lo, ph_hi; };
__global__ void __launch_bounds__(NWAVES * 64, 2) mk_fwd(Args args) {
    extern __shared__ __attribute__((aligned(16))) unsigned char lds[];
    Frame F;
    F.lds = (LAS unsigned char*)lds;
    F.wave = __builtin_amdgcn_readfirstlane((int)threadIdx.x >> 6);
    F.gw = blockIdx.x * NWAVES + F.wave; F.ngw = gridDim.x * NWAVES;
    F.X = args.out; F.ws = args.ws;
    for (int u = threadIdx.x; u < (LDS_BYTES - LDSCTL_OFF) / 4; u += NWAVES * 64) ((LAS unsigned*)(F.lds + LDSCTL_OFF))[u] = 0u;
    __syncthreads();
    const int lo = args.ph_lo, hi = args.ph_hi;
    unsigned* barw = (unsigned*)(args.ws + WS_CTL) + CW_BAR;
    XcdBarrier bar; bar.bar = barw; bar.x = 0; bar.st = nullptr;
    if (hi - lo > 1) bar = xcd_barrier_post(barw, (volatile LAS unsigned*)(F.lds + MISC_OFF) + 8);
    const int G = gridDim.x, bid = blockIdx.x;
    int ph = 0;
#define RUN() (lo <= ph && ph < hi)
#define SEAM() do { if (lo <= ph && ph + 1 < hi) xcd_barrier(bar); ++ph; } while (0)

    if (RUN()) p_prologue(F);
    SEAM();
    for (int f = 0; f < 2 * DEPTH; ++f) {
        const int l = f >> 1, sub = f & 1, nidx = 3 * l + (sub ? 2 : 0);
        unsigned char* wl = args.ws + WS_W + (size_t)l * W_LAYER;
        if (RUN()) {
            pg8::Gemm g{WSP(bf16, WS_XB), (const bf16*)(wl + (sub ? W_GU1 : W_GU0)), SEQ, 2 * FF, DM}; pg8::StaticOrder S; S.init(SEQ, 2 * FF, G, bid);
            pg8::EpiSwiglu E{WSP(bf16, WS_ACT), FF, WSP(pg8::u64_t, WS_SS) + (size_t)nidx * SEQ};
            pg8::gemm_phase<pg8::EpiSwiglu, pg8::StaticOrder, true, true>(F.lds, g, S, E);
        }
        SEAM();
        if (RUN()) {
            pg8::Gemm g{WSP(bf16, WS_ACT), (const bf16*)(wl + (sub ? W_D1 : W_D0)), SEQ, DM, FF}; pg8::StaticOrder S; S.init(SEQ, DM, G, bid);
            pg8::EpiResid E{F.X, WSP(bf16, WS_XB), WSP(pg8::u64_t, WS_SS) + (size_t)(nidx + 1) * SEQ, 0.5f};
            pg8::gemm_phase<pg8::EpiResid, pg8::StaticOrder, true, true>(F.lds, g, S, E);
        }
        SEAM();
        if (sub == 0) {
            const int kind = l % 3; const pg8::u64_t* ssm = WSP(pg8::u64_t, WS_SS) + (size_t)(3 * l + 1) * SEQ;
            if (RUN()) {
                pg8::Gemm g{WSP(bf16, WS_XB), (const bf16*)(wl + W_IN), SEQ, NQKV, DM}; pg8::StaticOrder S; S.init(SEQ, NQKV, G, bid);
                pg8::EpiQKV E{WSP(bf16, WS_QKV), NQKV, ssm, QSCALE, kind == 2 ? DM / 256 : 0};
                pg8::gemm_phase<pg8::EpiQKV, pg8::StaticOrder, true, true>(F.lds, g, S, E);
                if (kind == 0) p_fgate(F, l, ssm);
            }
            SEAM();
            if (kind == 0) {
                if (RUN()) p_qknorm_cumsum(F, l);
                SEAM();
#if MK_NAIVE_ATTN
                if (RUN()) p_attn_naive<0>(F);
#else
                if (RUN()) att::attn_phase<0>((char*)lds, WSP(bf16, WS_QKV), WSP(bf16, WS_OB), WSP(float, WS_CNEG));
#endif
                SEAM();
            } else if (kind == 1) {
                if (RUN()) p_conv(F, l);
                SEAM();
            } else {
#if MK_NAIVE_ATTN
                if (RUN()) p_attn_naive<2>(F);
#else
                if (RUN()) att::attn_phase<2>((char*)lds, WSP(bf16, WS_QKV), WSP(bf16, WS_OB), WSP(float, WS_CNEG));
#endif
                SEAM();
            }
            if (RUN()) {
                pg8::Gemm g{WSP(bf16, WS_OB), (const bf16*)(wl + W_OUT), SEQ, DM, DM}; pg8::StaticOrder S; S.init(SEQ, DM, G, bid);
                pg8::EpiResid E{F.X, WSP(bf16, WS_XB), WSP(pg8::u64_t, WS_SS) + (size_t)(3 * l + 2) * SEQ, 1.0f};
                pg8::gemm_phase<pg8::EpiResid, pg8::StaticOrder, true, true>(F.lds, g, S, E);
            }
            SEAM();
        }
    }
#undef RUN
#undef SEAM
}

extern "C" void kernel_launch(void* const* d_in, const int* in_sizes, int n_in, void* d_out, int out_size, void* d_ws, size_t ws_size, hipStream_t stream) {
    static int grid = 0;
    if (grid == 0) {
        if (n_in != 20 || in_sizes[0] != SEQ * DM || out_size != SEQ * DM || ws_size < WS_END) {
            fprintf(stderr, "kernel_launch: unexpected shapes (n_in %d, in0 %d, out %d, ws %zu; need ws >= %zu); nothing launched\n", n_in, n_in > 0 ? in_sizes[0] : -1, out_size, ws_size, (size_t)WS_END); grid = -1; return; }
        int dev = 0, cus = 0, per_cu = 0;
        if (hipGetDevice(&dev) != hipSuccess || hipDeviceGetAttribute(&cus, hipDeviceAttributeMultiprocessorCount, dev) != hipSuccess) { grid = -1; return; }
        if (hipFuncSetAttribute((const void*)mk_fwd, hipFuncAttributeMaxDynamicSharedMemorySize, LDS_BYTES) != hipSuccess) { fprintf(stderr, "kernel_launch: hipFuncSetAttribute failed\n"); grid = -1; return; }
        if (hipOccupancyMaxActiveBlocksPerMultiprocessor(&per_cu, (const void*)mk_fwd, NWAVES * 64, LDS_BYTES) != hipSuccess || per_cu < 1)
            fprintf(stderr, "kernel_launch: note: occupancy query reports %d workgroups per CU\n", per_cu);
        (void)hipGetLastError();
        grid = cus;
    }
    if (grid < 0) return;
    if (hipMemsetAsync((char*)d_ws + WS_CTL, 0, CTL_ZERO_BYTES, stream) != hipSuccess) { fprintf(stderr, "kernel_launch: memset failed\n"); return; }
    Args a{};
    for (int i = 0; i < 20; ++i) a.in[i] = (const float*)d_in[i];
    a.out = (float*)d_out; a.ws = (unsigned char*)d_ws;
#if MK_ONE_LAUNCH
    a.ph_lo = 0; a.ph_hi = N_PHASES;
    hipLaunchKernelGGL(mk_fwd, dim3(grid), dim3(NWAVES * 64), LDS_BYTES, stream, a);
#else
    for (int p = 0; p < N_PHASES; ++p) { a.ph_lo = p; a.ph_hi = p + 1;
        hipLaunchKernelGGL(mk_fwd, dim3(grid), dim3(NWAVES * 64), LDS_BYTES, stream, a); }
#endif
    const hipError_t le = hipPeekAtLastError();
    if (le != hipSuccess) fprintf(stderr, "kernel_launch: launch failed: %s\n", hipGetErrorName(le));
}
```

```cpp
#include <hip/hip_runtime.h>
#include <cstdio>
#include <cstdint>
#ifndef MK_ONE_LAUNCH
#define MK_ONE_LAUNCH 1
#endif
#ifndef MK_NAIVE_ATTN
#define MK_NAIVE_ATTN 0
#endif
#ifndef MK_PROBE
#define MK_PROBE 0
#endif
namespace pg8 {
#define PG8_LAS __attribute__((address_space(3)))
typedef unsigned short bf16_t;
typedef short bf16x8 __attribute__((ext_vector_type(8)));
typedef float f32x4 __attribute__((ext_vector_type(4)));
typedef unsigned u32x4 __attribute__((ext_vector_type(4)));
constexpr int BM = 256, BK = 64, HALF = 128, HTB = HALF * BK * 2  , STAGE_BYTES = 8 * HTB, NXCD = 8, WGM = 8;

__host__ __device__ __forceinline__ int lds_byte(int r, int c) { const int st = (r >> 4) * 2 + (c >> 5), rr = r & 15, cc = c & 31, ob = rr * 64 + cc * 2; return st * 1024 + (ob ^ (((ob >> 9) & 1) << 5)); }
__host__ __device__ __forceinline__ void stage_rc(int b, int& R, int& C) { const int st = b / 1024, sb = b % 1024, swz = sb ^ (((sb >> 9) & 1) << 5); R = (st >> 1) * 16 + swz / 64; C = (st & 1) * 32 + (swz % 64) / 2; }
__host__ __device__ __forceinline__ int perm32(int rho) { const int n = rho >> 4, i = rho & 15; return 8 * (i >> 2) + 4 * n + (i & 3); }

struct Unit { int pm, pn; };
struct Gemm { const bf16_t* A; const bf16_t* Bt; int M, N, K; };

struct StaticOrder {
    int nM, nN, nwg, G, c;
    __host__ __device__ void init(int M, int N, int G_, int c_) { nM = M / BM; nN = N / BM; nwg = nM * nN; G = G_; c = c_; }
    __host__ __device__ bool next(int i, Unit& u) const {
        const long L = (long)i * G + c; if (L >= nwg) return false;
        int wgid = (int)L; { const int q = nwg / NXCD, r = nwg % NXCD, xcd = wgid % NXCD, off = wgid / NXCD; wgid = (xcd < r ? xcd * (q + 1) : r * (q + 1) + (xcd - r) * q) + off; }
        const int nig = WGM * nN, gid = wgid / nig, fm = gid * WGM, gsz = (nM - fm) < WGM ? (nM - fm) : WGM;
        u.pm = fm + ((wgid % nig) % gsz); u.pn = (wgid % nig) / gsz; return true;
    }
    __device__ __forceinline__ void a_ready(const Unit&) const {}
    __device__ __forceinline__ void done(const Unit&) const {}
};


__device__ __forceinline__ unsigned cvt_pk_bf16(float lo, float hi) { unsigned r; asm volatile("v_cvt_pk_bf16_f32 %0, %1, %2" : "=v"(r) : "v"(lo), "v"(hi)); return r; }
constexpr float NORM_EPS = 1e-6f, INV_D = 1.0f / 2048.0f, SS_FIX = 16777216.0f, SS_UNFIX = 1.0f / 16777216.0f;
typedef unsigned long long u64_t;
__device__ __forceinline__ float ss_rstd(const u64_t* ss, int row) { return __builtin_amdgcn_rsqf((float)ss[row] * (SS_UNFIX * INV_D) + NORM_EPS); }
__device__ __forceinline__ float silu_mul(float g, float u) {
    const float e = __builtin_amdgcn_exp2f(g * -1.4426950408889634f);
    return g * u * __builtin_amdgcn_rcpf(1.0f + e);
}
struct EpiSwiglu {
    static constexpr bool PERM = true, AFTER_DRAIN = false;
    bf16_t* O; int ldc; const u64_t* ss;
    __device__ __forceinline__ void operator()(const f32x4 (&acc)[2][2][4][2], const Unit& u, int wr, int wc, int fr, int fq) const {
        const int row0 = u.pm * BM + wr * 64 + fr, col0 = u.pn * HALF + wc * 32 + 8 * fq;
#pragma unroll
        for (int ai = 0; ai < 2; ++ai)
#pragma unroll
            for (int m = 0; m < 4; ++m) { const int row = row0 + ai * HALF + m * 16;
                const float rs = ss_rstd(ss, row);
                const f32x4 g0 = acc[ai][0][m][0] * rs, g1 = acc[ai][0][m][1] * rs, u0 = acc[ai][1][m][0] * rs, u1 = acc[ai][1][m][1] * rs;
                u32x4 w; w.x = cvt_pk_bf16(silu_mul(g0[0], u0[0]), silu_mul(g0[1], u0[1])); w.y = cvt_pk_bf16(silu_mul(g0[2], u0[2]), silu_mul(g0[3], u0[3]));
                w.z = cvt_pk_bf16(silu_mul(g1[0], u1[0]), silu_mul(g1[1], u1[1])); w.w = cvt_pk_bf16(silu_mul(g1[2], u1[2]), silu_mul(g1[3], u1[3]));
                *(u32x4*)(O + (size_t)row * ldc + col0) = w; }
    }
};
struct EpiQKV {
    static constexpr bool PERM = true, AFTER_DRAIN = false;
    bf16_t* O; int ldc; const u64_t* ss; float qscale; int qtiles;
    __device__ __forceinline__ void operator()(const f32x4 (&acc)[2][2][4][2], const Unit& u, int wr, int wc, int fr, int fq) const {
        const int row0 = u.pm * BM + wr * 64 + fr, col0 = u.pn * BM + wc * 32 + 8 * fq;
        const float sc = (u.pn < qtiles) ? qscale : 1.0f;
#pragma unroll
        for (int ai = 0; ai < 2; ++ai)
#pragma unroll
            for (int m = 0; m < 4; ++m) { const int row = row0 + ai * HALF + m * 16;
                const float rs = ss_rstd(ss, row) * sc;
#pragma unroll
                for (int bj = 0; bj < 2; ++bj) { const f32x4 v0 = acc[ai][bj][m][0] * rs, v1 = acc[ai][bj][m][1] * rs;
                    u32x4 w; w.x = cvt_pk_bf16(v0[0], v0[1]); w.y = cvt_pk_bf16(v0[2], v0[3]); w.z = cvt_pk_bf16(v1[0], v1[1]); w.w = cvt_pk_bf16(v1[2], v1[3]);
                    *(u32x4*)(O + (size_t)row * ldc + col0 + bj * HALF) = w; } }
    }
};
struct EpiResid {
    static constexpr bool PERM = false, AFTER_DRAIN = false;
    float* X; bf16_t* XB; u64_t* ss_out; float alpha;
    __device__ __forceinline__ void operator()(const f32x4 (&acc)[2][2][4][2], const Unit& u, int wr, int wc, int fr, int fq) const {
        typedef unsigned u32x2v __attribute__((ext_vector_type(2)));
        const int row0 = u.pm * BM + wr * 64 + fr, col0 = u.pn * BM + wc * 32 + 4 * fq;
#pragma unroll
        for (int ai = 0; ai < 2; ++ai)
#pragma unroll
            for (int m = 0; m < 4; ++m) { const int row = row0 + ai * HALF + m * 16; const size_t off = (size_t)row * 2048 + col0; float sq = 0.f;
                f32x4 xo[2][2];
#pragma unroll
                for (int bj = 0; bj < 2; ++bj)
#pragma unroll
                    for (int n = 0; n < 2; ++n) xo[bj][n] = *(const f32x4*)(X + off + bj * HALF + n * 16);
#pragma unroll
                for (int bj = 0; bj < 2; ++bj)
#pragma unroll
                    for (int n = 0; n < 2; ++n) { const f32x4 xn = xo[bj][n] + acc[ai][bj][m][n] * alpha;
                        *(f32x4*)(X + off + bj * HALF + n * 16) = xn; sq += (xn[0] * xn[0] + xn[1] * xn[1]) + (xn[2] * xn[2] + xn[3] * xn[3]);
                        u32x2v w; w.x = cvt_pk_bf16(xn[0], xn[1]); w.y = cvt_pk_bf16(xn[2], xn[3]); *(u32x2v*)(XB + off + bj * HALF + n * 16) = w; }
                sq += __shfl_xor(sq, 16); sq += __shfl_xor(sq, 32);
                if (fq == 0) __hip_atomic_fetch_add(ss_out + row, (u64_t)(sq * SS_FIX), __ATOMIC_RELAXED, __HIP_MEMORY_SCOPE_AGENT); }
    }
};
template <class Epi, class Sched, bool ALIGN_EPI = false, bool SP2 = false>
__device__ __forceinline__ void gemm_phase(PG8_LAS unsigned char* lds, const Gemm g, const Sched& S, const Epi& E) {
    int tid_ = threadIdx.x; asm volatile("" : "+v"(tid_));
    const int tid = tid_, wid = __builtin_amdgcn_readfirstlane(tid >> 6), lane = tid & 63, wr = wid >> 2, wc = wid & 3, fr = lane & 15, fq = lane >> 4;
    const int K = g.K, nt = K / BK;
    unsigned voffA[2], voffB[2];
#pragma unroll
    for (int i = 0; i < 2; ++i) { int R, C; stage_rc(tid * 16 + i * 8192, R, C); const int Rb = Epi::PERM ? ((R & ~31) + perm32(R & 31)) : R;
        voffA[i] = (unsigned)(R * K + C) * 2u; voffB[i] = (unsigned)(Rb * K + C) * 2u; }
    const size_t kstep = (size_t)(BK * 2);
    const size_t hstep = (size_t)HALF * K * 2;
    const size_t tstep = 2 * hstep;
    const unsigned ldsw = (unsigned)wid * 1024u;
    const int aoff = lds_byte(wr * 64 + fr, fq * 8), boff = lds_byte(wc * 32 + fr, fq * 8);
#define PG8_SA(b, h) (((b) * 2 + (h)) * HTB)
#define PG8_SB(b, h) ((4 + (b) * 2 + (h)) * HTB)
#define PG8_STAGE(bufoff, gbase, voff) do { _Pragma("unroll") for (int _i = 0; _i < 2; ++_i) \
        __builtin_amdgcn_global_load_lds((const unsigned*)((const char*)(gbase) + (voff)[_i]), (PG8_LAS unsigned*)(lds + (bufoff) + ldsw + _i * 8192), 16, 0, 0); } while (0)
#define PG8_LDA(dst, b, h) do { _Pragma("unroll") for (int m = 0; m < 4; ++m) _Pragma("unroll") for (int k = 0; k < 2; ++k) dst[m][k] = *(const PG8_LAS bf16x8*)(lds + PG8_SA(b, h) + aoff + m * 2048 + k * 1024); } while (0)
#define PG8_LDB(dst, b, h) do { _Pragma("unroll") for (int n = 0; n < 2; ++n) _Pragma("unroll") for (int k = 0; k < 2; ++k) dst[n][k] = *(const PG8_LAS bf16x8*)(lds + PG8_SB(b, h) + boff + n * 2048 + k * 1024); } while (0)
#define PG8_MMA(ai, bj, At, Bt) do { __builtin_amdgcn_s_setprio(1); _Pragma("unroll") for (int m = 0; m < 4; ++m) _Pragma("unroll") for (int n = 0; n < 2; ++n) _Pragma("unroll") for (int k = 0; k < 2; ++k) \
        acc[ai][bj][m][n] = __builtin_amdgcn_mfma_f32_16x16x32_bf16(Bt[n][k], At[m][k], acc[ai][bj][m][n], 0, 0, 0); __builtin_amdgcn_s_setprio(0); } while (0)
#define PG8_WAIT_V(n) asm volatile("s_waitcnt vmcnt(" #n ")" ::: "memory")
#define PG8_WAIT_L(n) asm volatile("s_waitcnt lgkmcnt(" #n ")" ::: "memory")
#define PG8_BAR __builtin_amdgcn_s_barrier()
#define PG8_SCHED __builtin_amdgcn_sched_barrier(0)
    Unit cur, nxt; int ui = 0;
    if (!S.next(0, cur)) return;
    f32x4 acc[2][2][4][2];
#pragma unroll
    for (int a = 0; a < 2; ++a)
#pragma unroll
        for (int b = 0; b < 2; ++b)
#pragma unroll
            for (int m = 0; m < 4; ++m)
#pragma unroll
                for (int n = 0; n < 2; ++n) acc[a][b][m][n] = (f32x4){0.f, 0.f, 0.f, 0.f};
    bf16x8 At[4][2], B0[2][2], B1[2][2];
    const char* cA = (const char*)g.A + (size_t)cur.pm * tstep; const char* cB = (const char*)g.Bt + (size_t)cur.pn * tstep;
    S.a_ready(cur);
    if constexpr (SP2) {
        PG8_STAGE(PG8_SB(0, 0), cB, voffB); PG8_STAGE(PG8_SB(0, 1), cB + hstep, voffB); PG8_STAGE(PG8_SA(0, 0), cA, voffA); PG8_STAGE(PG8_SA(0, 1), cA + hstep, voffA);
        if (wr == 1) PG8_BAR;
        PG8_WAIT_V(2); PG8_BAR;
        PG8_STAGE(PG8_SB(1, 0), cB + kstep, voffB); PG8_STAGE(PG8_SA(1, 0), cA + kstep, voffA); PG8_STAGE(PG8_SB(1, 1), cB + hstep + kstep, voffB);
        PG8_WAIT_V(6); PG8_BAR;
    } else {
        PG8_STAGE(PG8_SB(0, 0), cB, voffB); PG8_STAGE(PG8_SA(0, 0), cA, voffA); PG8_STAGE(PG8_SB(0, 1), cB + hstep, voffB); PG8_STAGE(PG8_SA(0, 1), cA + hstep, voffA);
        if (wr == 1) PG8_BAR;
        PG8_WAIT_V(4); PG8_BAR;
        PG8_STAGE(PG8_SB(1, 0), cB + kstep, voffB); PG8_STAGE(PG8_SA(1, 0), cA + kstep, voffA); PG8_STAGE(PG8_SB(1, 1), cB + hstep + kstep, voffB);
        PG8_WAIT_V(6); PG8_BAR;
    }
    for (;;) {
        const bool has_next = S.next(ui + 1, nxt);
        const char* nA = has_next ? (const char*)g.A + (size_t)nxt.pm * tstep : cA; const char* nB = has_next ? (const char*)g.Bt + (size_t)nxt.pn * tstep : cB;
        for (int t = 0; t < nt; t += 2) {
            const bool last = (t == nt - 2);
            const char* a1 = cA + (size_t)(t + 1) * kstep;
            const char* a2 = last ? nA : cA + (size_t)(t + 2) * kstep; const char* b2 = last ? nB : cB + (size_t)(t + 2) * kstep;
            const char* a3 = a2 + kstep; const char* b3 = b2 + kstep;
            if (last && has_next) S.a_ready(nxt);
            if constexpr (SP2) {
            PG8_LDB(B0, 0, 0); PG8_LDB(B1, 0, 1); PG8_SCHED; PG8_LDA(At, 0, 0); PG8_STAGE(PG8_SA(1, 1), a1 + hstep, voffA);
            PG8_WAIT_V(8); PG8_WAIT_L(0); PG8_BAR; PG8_MMA(0, 0, At, B0); PG8_MMA(0, 1, At, B1); PG8_BAR; PG8_SCHED;
            PG8_LDA(At, 0, 1); PG8_STAGE(PG8_SB(0, 0), b2, voffB); PG8_STAGE(PG8_SB(0, 1), b2 + hstep, voffB); PG8_STAGE(PG8_SA(0, 0), a2, voffA);
            PG8_WAIT_V(8); PG8_WAIT_L(0); PG8_BAR; PG8_MMA(1, 0, At, B0); PG8_MMA(1, 1, At, B1); PG8_BAR; PG8_SCHED;
            PG8_LDB(B0, 1, 0); PG8_LDB(B1, 1, 1); PG8_SCHED; PG8_LDA(At, 1, 0); PG8_STAGE(PG8_SA(0, 1), a2 + hstep, voffA);
            PG8_WAIT_V(8); PG8_WAIT_L(0); PG8_BAR; PG8_MMA(0, 0, At, B0); PG8_MMA(0, 1, At, B1); PG8_BAR; PG8_SCHED;
            PG8_LDA(At, 1, 1); PG8_STAGE(PG8_SB(1, 0), b3, voffB); PG8_STAGE(PG8_SB(1, 1), b3 + hstep, voffB); PG8_STAGE(PG8_SA(1, 0), a3, voffA);
            PG8_WAIT_V(8); PG8_WAIT_L(0); PG8_BAR; PG8_MMA(1, 0, At, B0); PG8_MMA(1, 1, At, B1); PG8_BAR; PG8_SCHED;
            } else {
            PG8_LDB(B0, 0, 0); PG8_SCHED; PG8_LDA(At, 0, 0); PG8_STAGE(PG8_SA(1, 1), a1 + hstep, voffA);
            PG8_WAIT_L(8); PG8_BAR; PG8_WAIT_L(0); PG8_MMA(0, 0, At, B0); PG8_BAR; PG8_SCHED;
            PG8_LDB(B1, 0, 1); PG8_STAGE(PG8_SB(0, 0), b2, voffB);
            PG8_BAR; PG8_WAIT_L(0); PG8_MMA(0, 1, At, B1); PG8_BAR;
            PG8_LDA(At, 0, 1); PG8_STAGE(PG8_SA(0, 0), a2, voffA);
            PG8_BAR; PG8_WAIT_L(0); PG8_MMA(1, 0, At, B0); PG8_BAR; PG8_SCHED;
            PG8_STAGE(PG8_SB(0, 1), b2 + hstep, voffB);
            PG8_WAIT_V(6); PG8_BAR; PG8_MMA(1, 1, At, B1); PG8_BAR;
            PG8_LDB(B0, 1, 0); PG8_SCHED; PG8_LDA(At, 1, 0); PG8_STAGE(PG8_SA(0, 1), a2 + hstep, voffA);
            PG8_WAIT_L(8); PG8_BAR; PG8_WAIT_L(0); PG8_MMA(0, 0, At, B0); PG8_BAR; PG8_SCHED;
            PG8_LDB(B1, 1, 1); PG8_STAGE(PG8_SB(1, 0), b3, voffB);
            PG8_BAR; PG8_WAIT_L(0); PG8_MMA(0, 1, At, B1); PG8_BAR;
            PG8_LDA(At, 1, 1); PG8_STAGE(PG8_SA(1, 0), a3, voffA);
            PG8_BAR; PG8_WAIT_L(0); PG8_MMA(1, 0, At, B0); PG8_BAR; PG8_SCHED;
            PG8_STAGE(PG8_SB(1, 1), b3 + hstep, voffB);
            PG8_WAIT_V(6); PG8_BAR; PG8_MMA(1, 1, At, B1); PG8_BAR;
            }
        }
        if constexpr (ALIGN_EPI) { if (wr == 0) PG8_BAR; }
        if constexpr (!Epi::AFTER_DRAIN) { E(acc, cur, wr, wc, fr, fq); S.done(cur); }
        if (!has_next) break;
#pragma unroll
        for (int a = 0; a < 2; ++a)
#pragma unroll
            for (int b = 0; b < 2; ++b)
#pragma unroll
                for (int m = 0; m < 4; ++m)
#pragma unroll
                    for (int n = 0; n < 2; ++n) acc[a][b][m][n] = (f32x4){0.f, 0.f, 0.f, 0.f};
        cur = nxt; cA = nA; cB = nB; ++ui;
        if constexpr (ALIGN_EPI) { if (wr == 1) PG8_BAR; }
    }
    PG8_WAIT_V(0);
    if constexpr (!ALIGN_EPI) { if (wr == 0) PG8_BAR; }
    PG8_BAR;
    if constexpr (Epi::AFTER_DRAIN) { E.fused(acc, cur, wr, wc, fr, fq, lds, wid, lane); S.done(cur); }
#undef PG8_SA
#undef PG8_SB
#undef PG8_STAGE
#undef PG8_LDA
#undef PG8_LDB
#undef PG8_MMA
#undef PG8_WAIT_V
#undef PG8_WAIT_L
#undef PG8_BAR
#undef PG8_SCHED
}
}

namespace att {
typedef unsigned short bf16;
typedef short bf16x8 __attribute__((ext_vector_type(8)));
typedef short s16x4 __attribute__((ext_vector_type(4)));
typedef float f32x16 __attribute__((ext_vector_type(16)));
typedef float f32x4 __attribute__((ext_vector_type(4)));
typedef unsigned u32x4 __attribute__((ext_vector_type(4)));
constexpr int NW = 8, QBLK = 32, KVBLK = 64, QB = NW * QBLK, D = 128, PITCH = 6144, OPITCH = 2048, NQB = 8192 / QB;
constexpr int SHM_V = KVBLK * D * 2, SHM_K = KVBLK * D * 2;
constexpr int OFF_WS = 2 * SHM_V + 2 * SHM_K, OFF_BIAS = OFF_WS + NW * 64 * 4, OFF_FLAG = OFF_BIAS + 512, LDS_BYTES = OFF_FLAG + 128;
constexpr float THR2 = 8.f;
#define KSWZ(row, colB) ((row) * 256 + ((colB) ^ (((row) & 7) << 4)))
#define SBAR() __builtin_amdgcn_sched_barrier(0)
__device__ __forceinline__ int v_st(int k, int c) { const int kk = (k & ~0xC) | ((k & 4) << 1) | ((k & 8) >> 1); return ((kk >> 3) * 4 + (c >> 5)) * 512 + ((kk & 7) * 32 + (c & 31)) * 2; }
__device__ __forceinline__ int v_rd_base(int lane) { return ((lane & 3) << 3) | (((lane >> 2) & 3) << 6) | (((lane >> 4) & 1) << 5) | (((lane >> 5) & 1) << 8); }
constexpr int v_rd_off(int d0, int ks, int half) { return d0 * 512 + ks * 4096 + half * 2048; }
__device__ __forceinline__ int crow(int r, int hi) { return (r & 3) + 8 * (r >> 2) + 4 * hi; }
__device__ __forceinline__ unsigned cvtpk(float lo, float hi) { unsigned r; asm volatile("v_cvt_pk_bf16_f32 %0, %1, %2" : "=v"(r) : "v"(lo), "v"(hi)); return r; }
template <int MLIM> __device__ __forceinline__ void mask_tile(f32x16& p0, f32x16& p1, int dq) {
    const float NEG = -__builtin_inff();
#pragma unroll
    for (int r = 0; r < 16; ++r) { const int c = (r & 3) + 8 * (r >> 2);
        if (dq - c < MLIM) p0[r] = NEG;
        if (dq - c - 32 < MLIM) p1[r] = NEG; }
}
__device__ __forceinline__ void partialSM(f32x16& p0, f32x16& p1, float& m_reg, float& alpha) {
    float pmax = p0[0];
#pragma unroll
    for (int r = 1; r < 16; ++r) pmax = fmaxf(pmax, p0[r]);
#pragma unroll
    for (int r = 0; r < 16; ++r) pmax = fmaxf(pmax, p1[r]);
    { auto rr = __builtin_amdgcn_permlane32_swap(__float_as_uint(pmax), __float_as_uint(pmax), false, false);
      pmax = fmaxf(__uint_as_float(rr[0]), __uint_as_float(rr[1])); }
    float mn;
    if (__builtin_expect(__all((pmax - m_reg) <= THR2), 1)) { mn = m_reg; alpha = 1.f; }
    else { mn = fmaxf(m_reg, pmax); alpha = __builtin_amdgcn_exp2f(m_reg - mn); m_reg = mn; }
#pragma unroll
    for (int r = 0; r < 16; ++r) { p0[r] -= mn; p1[r] -= mn; }
#pragma unroll
    for (int r = 0; r < 16; ++r) p0[r] = __builtin_amdgcn_exp2f(p0[r]);
}
#define ATT_PK4(P, B_, OUT) do { unsigned a0 = cvtpk(P[B_+0], P[B_+1]), a1 = cvtpk(P[B_+2], P[B_+3]);                          \
        unsigned b0 = cvtpk(P[B_+4], P[B_+5]), b1 = cvtpk(P[B_+6], P[B_+7]);                                             \
        auto r0 = __builtin_amdgcn_permlane32_swap(a0, b0, false, false); auto r1 = __builtin_amdgcn_permlane32_swap(a1, b1, false, false); \
        u32x4 w = {r0[0], r1[0], r0[1], r1[1]}; OUT = *reinterpret_cast<bf16x8*>(&w); } while (0)
__device__ __forceinline__ void finishSM(f32x16& p0, f32x16& p1, float alpha, float& l_reg, bf16x8& pa0, bf16x8& pa1, bf16x8& pa2, bf16x8& pa3) {
#pragma unroll
    for (int r = 0; r < 16; ++r) p1[r] = __builtin_amdgcn_exp2f(p1[r]);
    float ps = 0;
#pragma unroll
    for (int r = 0; r < 16; ++r) ps += p0[r];
#pragma unroll
    for (int r = 0; r < 16; ++r) ps += p1[r];
    { auto rr = __builtin_amdgcn_permlane32_swap(__float_as_uint(ps), __float_as_uint(ps), false, false);
      ps = __uint_as_float(rr[0]) + __uint_as_float(rr[1]); }
    l_reg = l_reg * alpha + ps;
    ATT_PK4(p0, 0, pa0); ATT_PK4(p0, 8, pa1); ATT_PK4(p1, 0, pa2); ATT_PK4(p1, 8, pa3);
}
__device__ __forceinline__ void sb_partial(f32x16& p0, f32x16& p1, float& R, int dq, bool needmask, int hi) {
    float G[8];
#pragma unroll
    for (int j = 0; j < 8; ++j) { float lom[4];
#pragma unroll
        for (int e = 0; e < 4; ++e) { const int r = 4 * (j & 3) + e; const float z = (j < 4) ? p0[r] : p1[r];
            const float ex = __builtin_amdgcn_exp2f(-__builtin_fabsf(z)); const float lg = __builtin_amdgcn_logf(1.0f + ex);
            float ls = fminf(z, 0.f) - lg; float lo = ls - z;
            if (needmask) { const int c = e + 8 * (j & 3) + ((j < 4) ? 0 : 32); if (dq - c < 1) { lo = 0.f; ls = -__builtin_inff(); } }
            lom[e] = lo; if (j < 4) p0[r] = ls; else p1[r] = ls; }
        const float w2 = lom[3], w1 = w2 + lom[2], w0 = w1 + lom[1]; G[j] = w0 + lom[0];
        const int rb = 4 * (j & 3);
        if (j < 4) { p0[rb + 2] += w2; p0[rb + 1] += w1; p0[rb + 0] += w0; } else { p1[rb + 2] += w2; p1[rb + 1] += w1; p1[rb + 0] += w0; }
    }
    float S = R;
#pragma unroll
    for (int j = 7; j >= 0; --j) { auto rr = __builtin_amdgcn_permlane32_swap(__float_as_uint(G[j]), __float_as_uint(G[j]), false, false);
        const float Pn = hi ? __uint_as_float(rr[0]) : __uint_as_float(rr[1]);
        const float above = S + (hi ? 0.f : Pn);
        const int rb = 4 * (j & 3);
#pragma unroll
        for (int e = 0; e < 4; ++e) { if (j < 4) p0[rb + e] += above; else p1[rb + e] += above; }
        S += (hi ? (Pn + G[j]) : (G[j] + Pn)); }
    R = S;
}
__device__ __forceinline__ void sb_finish(f32x16& p0, f32x16& p1, bf16x8& pa0, bf16x8& pa1, bf16x8& pa2, bf16x8& pa3) {
#pragma unroll
    for (int r = 0; r < 16; ++r) { p0[r] = __builtin_amdgcn_exp2f(p0[r]); p1[r] = __builtin_amdgcn_exp2f(p1[r]); }
    ATT_PK4(p0, 0, pa0); ATT_PK4(p0, 8, pa1); ATT_PK4(p1, 0, pa2); ATT_PK4(p1, 8, pa3);
}
template <int KB, int KIND>
__device__ __forceinline__ void qkt(f32x16& p0, f32x16& p1, const char* K_lds, const char* B_lds, int r32, int hi, const bf16x8* qr) {
    if (KIND == 0) { const char* bb = B_lds + KB * 256 + hi * 16;
#pragma unroll
        for (int i = 0; i < 4; ++i) { const f32x4 b0 = *reinterpret_cast<const f32x4*>(bb + i * 32), b1 = *reinterpret_cast<const f32x4*>(bb + 128 + i * 32);
#pragma unroll
            for (int e = 0; e < 4; ++e) { p0[4 * i + e] = b0[e]; p1[4 * i + e] = b1[e]; } } }
    else { p0 = f32x16{}; p1 = f32x16{}; }
    const char* kb[4];
#pragma unroll
    for (int dd = 0; dd < 4; ++dd) kb[dd] = K_lds + KB * SHM_K + KSWZ(r32, (dd * 16 + hi * 8) * 2);
#pragma unroll
    for (int d0 = 0; d0 < 8; ++d0) { const char* a = kb[d0 & 3] + (d0 >> 2) * 128;
        bf16x8 b0 = *reinterpret_cast<const bf16x8*>(a);
        bf16x8 b1 = *reinterpret_cast<const bf16x8*>(a + 32 * 256);
        p0 = __builtin_amdgcn_mfma_f32_32x32x16_bf16(b0, qr[d0], p0, 0, 0, 0);
        p1 = __builtin_amdgcn_mfma_f32_32x32x16_bf16(b1, qr[d0], p1, 0, 0, 0);
        if (KIND == 2 && (d0 & 1)) SBAR(); }
}
template <int VB>
__device__ __forceinline__ void pv_tile(f32x16* o, int vb0, bf16x8 pa0, bf16x8 pa1, bf16x8 pa2, bf16x8 pa3) {
#define TRRD(dst, off) asm volatile("ds_read_b64_tr_b16 %0, %1 offset:%2" : "=&v"(dst) : "v"(vb0), "i"(off) : "memory")
#define PV_D0(d0) do { s16x4 l0, l1, l2, l3, h0, h1, h2, h3; constexpr int b_ = VB * SHM_V + v_rd_off(d0, 0, 0); \
        TRRD(l0, b_); TRRD(h0, b_ + 2048); TRRD(l1, b_ + 4096); TRRD(h1, b_ + 6144); TRRD(l2, b_ + 8192); TRRD(h2, b_ + 10240); TRRD(l3, b_ + 12288); TRRD(h3, b_ + 14336); \
        asm volatile("s_waitcnt lgkmcnt(0)" ::: "memory"); SBAR();   \
        o[d0] = __builtin_amdgcn_mfma_f32_32x32x16_bf16(pa0, (bf16x8){l0[0], l0[1], l0[2], l0[3], h0[0], h0[1], h0[2], h0[3]}, o[d0], 0, 0, 0);   \
        o[d0] = __builtin_amdgcn_mfma_f32_32x32x16_bf16(pa1, (bf16x8){l1[0], l1[1], l1[2], l1[3], h1[0], h1[1], h1[2], h1[3]}, o[d0], 0, 0, 0);   \
        o[d0] = __builtin_amdgcn_mfma_f32_32x32x16_bf16(pa2, (bf16x8){l2[0], l2[1], l2[2], l2[3], h2[0], h2[1], h2[2], h2[3]}, o[d0], 0, 0, 0);   \
        o[d0] = __builtin_amdgcn_mfma_f32_32x32x16_bf16(pa3, (bf16x8){l3[0], l3[1], l3[2], l3[3], h3[0], h3[1], h3[2], h3[3]}, o[d0], 0, 0, 0); } while (0)
    PV_D0(0); PV_D0(1); PV_D0(2); PV_D0(3);
#undef PV_D0
#undef TRRD
}
struct BlockRef { const bf16* Q; const bf16* K; const bf16* V; bf16* O; const float* CB; int P0; };
struct Seam { bf16x8 qr[8]; bf16x8 st_v0, st_v1, st_k0, st_k1; f32x4 st_b; };
template <int KIND> __device__ __forceinline__ int first_kb(int P0) { return P0 + QB - KVBLK; }
#define AROW(p, k0, rr) ((p) + (size_t)((k0) + (rr)) * PITCH + sc)
#define VMW() asm volatile("s_waitcnt vmcnt(0)" ::: "memory")
#define VMWN(n) asm volatile("s_waitcnt vmcnt(%0)" :: "i"(n) : "memory")
#define LD8(p) (*reinterpret_cast<const bf16x8*>(p))
#define SLOAD_B(R_, k0) do { if (KIND == 0 && tid < 16) { const f32x4 t_ = *(const f32x4*)((R_).CB + (k0) + 4 * tid); const float cr_ = (R_).CB[(R_).P0]; S.st_b = t_ - cr_; } } while (0)
#define SLOAD_H(R_, k0) do { S.st_v0 = LD8(AROW((R_).V, k0, sr)); S.st_v1 = LD8(AROW((R_).V, k0, 32 + sr)); S.st_k0 = LD8(AROW((R_).K, k0, sr)); S.st_k1 = LD8(AROW((R_).K, k0, 32 + sr)); SLOAD_B(R_, k0); } while (0)
#define SWRITE_HK(bf) do { *(bf16x8*)(K_lds + (bf) * SHM_K + kws) = S.st_k0; *(bf16x8*)(K_lds + (bf) * SHM_K + kws + 32 * 256) = S.st_k1; \
                           if (KIND == 0 && tid < 16) *(f32x4*)(B_lds + (bf) * 256 + tid * 16) = S.st_b; } while (0)
#define SWRITE_HV(bf) do { *(bf16x8*)(V_lds + (bf) * SHM_V + vst0) = S.st_v0; *(bf16x8*)(V_lds + (bf) * SHM_V + vst1) = S.st_v1; } while (0)
#define SWRITE_H(bf) do { SWRITE_HV(bf); SWRITE_HK(bf); } while (0)
template <int KIND>
__device__ __forceinline__ void attn_prime(const BlockRef& cur, char* lds, Seam& S, const int tid) {
    const int wid = __builtin_amdgcn_readfirstlane(tid >> 6), lane = tid & 63, r32 = lane & 31, hi = lane >> 5;
    const int sr = tid >> 4, sc = (tid & 15) * 8, kws = KSWZ(sr, sc * 2); char* K_lds = lds + 2 * SHM_V; char* B_lds = lds + OFF_BIAS;
    const int kb0 = first_kb<KIND>(cur.P0);
#pragma unroll
    for (int d0 = 0; d0 < 8; ++d0) S.qr[d0] = LD8(cur.Q + (size_t)(wid * QBLK + r32) * PITCH + d0 * 16 + hi * 8);
    SLOAD_H(cur, kb0); VMW(); SWRITE_HK(0);
    __syncthreads();
}
template <int KIND>
__device__ __forceinline__ void attn_block(const BlockRef& cur, const BlockRef& nxt, char* lds, Seam& S, const int tid) {
    constexpr int MLIM = (KIND == 2) ? 1 : 0;
    const int wid = __builtin_amdgcn_readfirstlane(tid >> 6), lane = tid & 63, r32 = lane & 31, hi = lane >> 5;
    const int NT0 = cur.P0 / KVBLK + QB / KVBLK; int NT = NT0;
    const int kbn = first_kb<KIND>(nxt.P0);
    const int qlo = cur.P0 + wid * QBLK, qm = qlo + r32 - 4 * hi;
    char* V_lds = lds; char* K_lds = lds + 2 * SHM_V; char* B_lds = lds + OFF_BIAS;
    float* ws = (float*)(lds + OFF_WS) + wid * 64; float* li_l = ws, * al_l = ws + 32;
    float m_reg = -1e30f, l_reg = 0.f, R = 0.f; f32x16 o[4] = {};
    const int sr = tid >> 4, sc = (tid & 15) * 8, vst0 = v_st(sr, sc), vst1 = v_st(32 + sr, sc), kws = KSWZ(sr, sc * 2);
    const int vb0 = (int)(uintptr_t)V_lds + v_rd_base(lane);
#define RESC(a) do { if (KIND == 0) { if (__any((a) < 1.f)) { if (hi == 0) al_l[r32] = (a); asm volatile("s_waitcnt lgkmcnt(0)" ::: "memory");              \
                     for (int d_ = 0; d_ < 4; ++d_) for (int r = 0; r < 16; ++r) o[d_][r] *= al_l[crow(r, hi)]; } } } while (0)
#define KBASE(t) ((NT0 - 1 - (t)) * KVBLK)
#define NEEDM(kb_) ((kb_) + KVBLK - 1 + MLIM > qlo)
#define SM1(PX0, PX1, alX, t) do { const int kb_ = KBASE(t); if (KIND == 0) { if (NEEDM(kb_)) mask_tile<0>(PX0, PX1, qm - kb_); partialSM(PX0, PX1, m_reg, alX); } \
                                   else { sb_partial(PX0, PX1, R, qm - kb_, NEEDM(kb_), hi); sb_finish(PX0, PX1, pa0, pa1, pa2, pa3); } } while (0)
#define SM2(PY0, PY1, alY) do { if (KIND == 0) finishSM(PY0, PY1, alY, l_reg, pa0, pa1, pa2, pa3); } while (0)
    constexpr int NQL = 8;
#define SEAM_K0() do { VMWN(NQL); SWRITE_HK(0); SBAR(); } while (0)
    f32x16 pA0, pA1, pB0, pB1; float alA = 1.f, alB = 1.f; bf16x8 pa0, pa1, pa2, pa3;
    SWRITE_HV(0); SBAR();
    if (NT > 1) SLOAD_H(cur, KBASE(1));
    SBAR(); qkt<0, KIND>(pA0, pA1, K_lds, B_lds, r32, hi, S.qr);
    SM1(pA0, pA1, alA, 0);
    if (NT > 1) { VMW(); SWRITE_H(1); }
    __syncthreads();
#define HALF_STEP(PX0, PX1, alX, PY0, PY1, alY, t, KB, VB, SB, CHK) do {                                                      \
        SBAR(); qkt<KB, KIND>(PX0, PX1, K_lds, B_lds, r32, hi, S.qr);                                             \
        SM2(PY0, PY1, alY); SBAR();                                                           \
        if ((t) + 1 < NT) { SLOAD_H(cur, KBASE((t) + 1)); SBAR(); }                                               \
        pv_tile<VB>(o, vb0, pa0, pa1, pa2, pa3); SM1(PX0, PX1, alX, (t));                                        \
        if (KIND == 2 && (CHK)) { const bool wd_ = __all(R < -200.f); if (lane == 0) flg[wid] = wd_ ? 1 : 0; }            \
        __syncthreads();                                                                                                      \
        if (KIND == 2 && (CHK)) { const int4 f0_ = *(const int4*)flg, f1_ = *(const int4*)(flg + 4);                          \
            done_all = (f0_.x & f0_.y & f0_.z & f0_.w & f1_.x & f1_.y & f1_.z & f1_.w) != 0; }                                \
        if ((t) + 1 < NT) { VMW(); SWRITE_H(SB); }                                                                          \
        RESC(alX); __syncthreads(); } while (0)
    int* flg = (int*)(lds + OFF_FLAG); bool done_all = false;
    for (int t = 1; t + 1 < NT; t += 2) {
        HALF_STEP(pB0, pB1, alB, pA0, pA1, alA, t, 1, 0, 0, false);
        HALF_STEP(pA0, pA1, alA, pB0, pB1, alB, t + 1, 0, 1, 1, true);
        if (KIND == 2 && done_all) NT = t + 3;
    }
    constexpr bool even = true;
    if (even) { SBAR(); qkt<1, KIND>(pB0, pB1, K_lds, B_lds, r32, hi, S.qr); SBAR(); }
    SLOAD_H(nxt, kbn); SBAR();
#pragma unroll
    for (int d0 = 0; d0 < 8; ++d0) S.qr[d0] = LD8(nxt.Q + (size_t)(wid * QBLK + r32) * PITCH + d0 * 16 + hi * 8);
    SBAR();
    SM2(pA0, pA1, alA); SBAR();
    pv_tile<0>(o, vb0, pa0, pa1, pa2, pa3);
    if (even) { SM1(pB0, pB1, alB, NT - 1); __syncthreads(); RESC(alB);
        SM2(pB0, pB1, alB); SBAR(); pv_tile<1>(o, vb0, pa0, pa1, pa2, pa3); }
    SBAR(); SEAM_K0();
    float rli[16];
    if (KIND == 0) { if (hi == 0) li_l[r32] = l_reg; asm volatile("s_waitcnt lgkmcnt(0)" ::: "memory");
#pragma unroll
        for (int r = 0; r < 16; ++r) rli[r] = __builtin_amdgcn_rcpf(li_l[crow(r, hi)]); }
    else {
#pragma unroll
        for (int r = 0; r < 16; ++r) rli[r] = 1.f; }
    bf16* Ow = cur.O + (size_t)(wid * QBLK) * OPITCH;
#pragma unroll
    for (int r = 0; r < 16; ++r) { const int orow = crow(r, hi);
#pragma unroll
        for (int d0 = 0; d0 < 4; ++d0) { const float v = o[d0][r] * rli[r]; const float vn = __shfl_xor(v, 1);
            if ((r32 & 1) == 0) *(unsigned*)(Ow + (size_t)orow * OPITCH + d0 * 32 + r32) = cvtpk(v, vn); } }
    __syncthreads();
#undef RESC
#undef KBASE
#undef NEEDM
#undef SM1
#undef SM2
#undef SEAM_K0
#undef HALF_STEP
}
#undef AROW
#undef VMW
#undef VMWN
#undef LD8
#undef SLOAD_B
#undef SLOAD_H
#undef SWRITE_HK
#undef SWRITE_HV
#undef SWRITE_H
template <int KIND>
__device__ __forceinline__ void attn_phase(char* lds, const bf16* QKV, bf16* OB, const float* CNEG) {
    const int total = 16 * (NQB / 2), stride = gridDim.x;
    int L = blockIdx.x; if (L >= total) return;
    int pass = 0;
#define ITEM_REF(L_, pass_, ref) do { const int xcd_ = (L_) & 7, k_ = (L_) >> 3, h_ = xcd_ * 2 + (k_ >> 4), x_ = k_ & 15, qb_ = (pass_) ? (NQB - 1 - x_) : x_; \
        ref.Q = QKV + (size_t)qb_ * QB * PITCH + h_ * D; ref.K = QKV + 2048 + h_ * D; ref.V = QKV + 4096 + h_ * D; ref.O = OB + (size_t)qb_ * QB * OPITCH + h_ * D; \
        ref.CB = CNEG + (size_t)h_ * 8192; ref.P0 = qb_ * QB; } while (0)
    BlockRef cur; ITEM_REF(L, 0, cur);
    Seam S; S.st_b = f32x4{0.f, 0.f, 0.f, 0.f};
    int tid = threadIdx.x; asm volatile("" : "+v"(tid));
    attn_prime<KIND>(cur, lds, S, tid);
    for (;;) {
        const bool more_pass = pass == 0, more_item = L + stride < total, last = !more_pass && !more_item;
        int passn = pass + 1, Ln = L;
        if (!more_pass) { passn = 0; Ln = more_item ? L + stride : L; }
        BlockRef nxt; if (last) nxt = cur; else ITEM_REF(Ln, passn, nxt);
        attn_block<KIND>(cur, nxt, lds, S, tid);
        if (last) break;
        cur = nxt; pass = passn; L = Ln;
    }
#undef ITEM_REF
}
#undef KSWZ
#undef SBAR
#undef ATT_PK4
}

constexpr int NWAVES = 8;
constexpr int SEQ = 8192, DM = 2048, FF = 5632, NH = 16, HD = 128, DEPTH = 4, NQKV = 3 * DM, FOXN = 3 * DM + NH;
constexpr float LOG2E = 1.4426950408889634f;
constexpr float QSCALE = 0.08838834764831845f * LOG2E;
constexpr float EPS = 1e-6f;
constexpr size_t MiB = 1u << 20;
constexpr size_t WS_CTL = 0, CTL_ZERO_BYTES = 2 * MiB;
constexpr size_t WS_SS = 1 * MiB;
constexpr size_t WS_CNEG = 2 * MiB;
constexpr size_t WS_LOGF = 3 * MiB;
constexpr size_t WS_XB = 4 * MiB;
constexpr size_t WS_QKV = 36 * MiB;
constexpr size_t WS_OB = 132 * MiB;
constexpr size_t WS_ACT = 164 * MiB;
constexpr size_t WS_W = 256 * MiB, W_LAYER = 164 * MiB;
constexpr size_t W_GU0 = 0, W_D0 = 44 * MiB, W_GU1 = 66 * MiB, W_D1 = 110 * MiB, W_IN = 132 * MiB, W_OUT = 156 * MiB;
constexpr size_t WS_END = WS_W + DEPTH * W_LAYER;
constexpr int CW_BAR = 4096;
constexpr int RING_BYTES = 131072, LDSCTL_OFF = RING_BYTES, MISC_OFF = LDSCTL_OFF + 320, LDS_BYTES = 147456;
constexpr int N_PHASES = 31;

#define GAS __attribute__((address_space(1)))
#define LAS __attribute__((address_space(3)))
typedef unsigned short bf16;
typedef unsigned v4u __attribute__((ext_vector_type(4)));
typedef unsigned v2u __attribute__((ext_vector_type(2)));
typedef float f32x4 __attribute__((ext_vector_type(4)));
#define LDS_WAIT() asm volatile("s_waitcnt lgkmcnt(0)" ::: "memory")
#define VM_WAIT() asm volatile("s_waitcnt vmcnt(0)" ::: "memory")
__device__ __forceinline__ unsigned f2bf(float f) { unsigned u = __builtin_bit_cast(unsigned, f); return (u + 0x7fffu + ((u >> 16) & 1u)) >> 16; }
__device__ __forceinline__ unsigned pk2(float lo, float hi) { return f2bf(lo) | (f2bf(hi) << 16); }
__device__ __forceinline__ float bf_lo(unsigned w) { return __uint_as_float(w << 16); }
__device__ __forceinline__ float bf_hi(unsigned w) { return __uint_as_float(w & 0xffff0000u); }

#define XB_TMO      128
#define XB_XCNT(j)  (256  + 64 * (j))
#define XB_XSUB(j)  (1280 + 64 * (j))
#define XB_XGEN(j)  (2304 + 64 * (j))
#define XB_TOP      3328
#define XB_TOPGEN   3392
#define XCD_BAR_WORDS 3456
#define XB_SPIN_CAP (1u << 18)

__device__ __forceinline__ unsigned xb_ld(unsigned* p)              { return __hip_atomic_load(p, __ATOMIC_RELAXED, __HIP_MEMORY_SCOPE_AGENT); }
__device__ __forceinline__ unsigned xb_add(unsigned* p, unsigned v) { return __hip_atomic_fetch_add(p, v, __ATOMIC_RELAXED, __HIP_MEMORY_SCOPE_AGENT); }
__device__ __forceinline__ unsigned xb_xcc_id() { return (unsigned)__builtin_amdgcn_s_getreg((3 << 11) | 20) & 0xFu; }
#define XB_SPIN(cond, bar) do { unsigned _sp = 0; while (cond) { __builtin_amdgcn_s_sleep(1); \
    if ((++_sp & 255u) == 0u) { if (xb_ld(&(bar)[XB_TMO])) break; if (_sp > XB_SPIN_CAP) { atomicAdd(&(bar)[XB_TMO], 1u); break; } } } } while (0)

struct XcdBarrier {
    unsigned* bar; unsigned x;
    volatile LAS unsigned* st;
};

__device__ __forceinline__ XcdBarrier xcd_barrier_post(unsigned* bar, volatile LAS unsigned* st) {
    XcdBarrier b; b.bar = bar; b.x = xb_xcc_id(); b.st = st;
    if (threadIdx.x == 0) (void)xb_add(&bar[XB_XCNT(b.x)], 1u);
    return b;
}
__device__ __forceinline__ void xcd_barrier_complete(unsigned* bar, unsigned x, unsigned& nloc, unsigned& nx) {
    const unsigned G = gridDim.x * gridDim.y * gridDim.z;
    unsigned sum, cnt, mine, sp = 0u;
    for (;;) {
        sum = 0u; cnt = 0u; mine = 0u;
#pragma unroll
        for (unsigned j = 0; j < 16; ++j) { const unsigned c = xb_ld(&bar[XB_XCNT(j)]); sum += c; cnt += (c > 0u) ? 1u : 0u; mine = (j == x) ? c : mine; }
        if (sum == G) break;
        __builtin_amdgcn_s_sleep(1);
        if ((++sp & 255u) == 0u) { if (xb_ld(&bar[XB_TMO])) break; if (sp > XB_SPIN_CAP) { atomicAdd(&bar[XB_TMO], 1u); break; } }
    }
    nloc = mine > 0u ? mine : 1u; nx = cnt > 0u ? cnt : 1u;
}

__device__ __forceinline__ void xcd_barrier(const XcdBarrier& b) {
    asm volatile("s_waitcnt vmcnt(0)" ::: "memory");
    __syncthreads();
    if (threadIdx.x == 0) {
        unsigned* bar = b.bar;
        __builtin_amdgcn_s_waitcnt(0);
        unsigned nloc = b.st[0], nx = b.st[1];
        if (nloc == 0u) { xcd_barrier_complete(bar, b.x, nloc, nx); b.st[0] = nloc; b.st[1] = nx; }
        const unsigned old = xb_add(&bar[XB_XSUB(b.x)], 1u);
        const unsigned gen = old / nloc;
        if (old + 1u == (gen + 1u) * nloc) {
            __builtin_amdgcn_fence(__ATOMIC_RELEASE, "agent");
            asm volatile("s_waitcnt vmcnt(0)" ::: "memory");
            const unsigned og = xb_add(&bar[XB_TOP], 1u);
            const unsigned tg = og / nx;
            if (og + 1u == (tg + 1u) * nx) xb_add(&bar[XB_TOPGEN], 1u);
            else XB_SPIN(xb_ld(&bar[XB_TOPGEN]) == tg, bar);
            __builtin_amdgcn_fence(__ATOMIC_ACQUIRE, "agent");
            xb_add(&bar[XB_XGEN(b.x)], 1u);
            asm volatile("s_waitcnt vmcnt(0)" ::: "memory");
        } else {
            XB_SPIN(xb_ld(&bar[XB_XGEN(b.x)]) == gen, bar);
            __builtin_amdgcn_fence(__ATOMIC_ACQUIRE, "agent");
            asm volatile("s_waitcnt vmcnt(0)" ::: "memory");
        }
    }
    __syncthreads();
}

struct Frame {
    LAS unsigned char* lds;
    int wave, gw, ngw;
    float* X;
    unsigned char* ws;
};
typedef const __attribute__((address_space(4))) char* kptr_t;
__device__ __forceinline__ const float* in_ptr(int k) {
    kptr_t kp = (kptr_t)__builtin_amdgcn_kernarg_segment_ptr(); asm volatile("" : "+s"(kp));
    return *(const float* const __attribute__((address_space(4)))*)(kp + 8 * k);
}
#define WSP(T, off) ((T*)(F.ws + (off)))
__device__ __forceinline__ int fresh_tid() { int t = threadIdx.x; asm volatile("" : "+v"(t)); return t; }
__device__ __forceinline__ float wave_sum(float v) {
#pragma unroll
    for (int o = 1; o < 64; o <<= 1) v += __shfl_xor(v, o);
    return v;
}
__device__ __forceinline__ float wave_max(float v) {
#pragma unroll
    for (int o = 1; o < 64; o <<= 1) v = fmaxf(v, __shfl_xor(v, o));
    return v;
}
__device__ __forceinline__ void tr_item(const float* W, size_t ldw, const float* gain, int K, bf16* WT, int dst_row0, int k0, int n0, LAS float* scr, int lane) {
    float v[32];
    const float* src = W + (size_t)(k0 + (lane >> 5)) * ldw + n0 + (lane & 31);
#pragma unroll
    for (int i = 0; i < 32; ++i) v[i] = src[(size_t)(2 * i) * ldw];
    if (gain) {
#pragma unroll
        for (int i = 0; i < 32; ++i) v[i] *= gain[k0 + 2 * i + (lane >> 5)]; }
#pragma unroll
    for (int i = 0; i < 32; ++i) scr[(2 * i + (lane >> 5)) * 33 + (lane & 31)] = v[i];
    LDS_WAIT(); asm volatile("" ::: "memory");
    const int c = lane & 7;
#pragma unroll
    for (int j = 0; j < 4; ++j) { const int n = (lane >> 3) + 8 * j; const LAS float* s = scr + (8 * c) * 33 + n;
        v4u o; o.x = pk2(s[0 * 33], s[1 * 33]); o.y = pk2(s[2 * 33], s[3 * 33]); o.z = pk2(s[4 * 33], s[5 * 33]); o.w = pk2(s[6 * 33], s[7 * 33]);
        *(GAS v4u*)(WT + (size_t)(dst_row0 + n) * K + k0 + 8 * c) = o; }
    LDS_WAIT(); asm volatile("" ::: "memory");
}
#define ROW_ID(n0) (n0)
#define ROW_GATE(n0) ((((n0) >> 7) << 8) + ((n0) & 127))
#define ROW_UP(n0) ((((n0) >> 7) << 8) + ((n0) & 127) + 128)
#define TR_MAT(Wsrc, LDW, NCOLS, GAIN, KK, DST, ROWMAP) do { const int nblk_ = (NCOLS) / 32; const int nitems_ = ((KK) / 64) * nblk_; \
        while (it < base + nitems_) { const int r_ = it - base; const int kb_ = r_ / nblk_, nb_ = r_ % nblk_; const int n0_ = nb_ * 32; \
            tr_item((Wsrc), (size_t)(LDW), (GAIN), (KK), (DST), ROWMAP(n0_), kb_ * 64, n0_, scr, lane); it += F.ngw; } base += nitems_; } while (0)
__device__ __forceinline__ void p_prologue(Frame& F) {
    const int lane = fresh_tid() & 63;
    LAS float* scr = (LAS float*)(F.lds + F.wave * 16384);
    int it = F.gw, base = 0;
    for (int l = 0; l < DEPTH; ++l) {
        unsigned char* wl = F.ws + WS_W + (size_t)l * W_LAYER;
        const float* g1 = in_ptr(1) + l * DM; const float* gm = in_ptr(2) + l * DM; const float* g2 = in_ptr(3) + l * DM;
        const size_t offGU = (size_t)l * DM * FF, offD = (size_t)l * FF * DM;
        TR_MAT(in_ptr(4) + offGU, FF, FF, g1, DM, (bf16*)(wl + W_GU0), ROW_GATE);
        TR_MAT(in_ptr(5) + offGU, FF, FF, g1, DM, (bf16*)(wl + W_GU0), ROW_UP);
        TR_MAT(in_ptr(6) + offD, DM, DM, (const float*)nullptr, FF, (bf16*)(wl + W_D0), ROW_ID);
        TR_MAT(in_ptr(7) + offGU, FF, FF, g2, DM, (bf16*)(wl + W_GU1), ROW_GATE);
        TR_MAT(in_ptr(8) + offGU, FF, FF, g2, DM, (bf16*)(wl + W_GU1), ROW_UP);
        TR_MAT(in_ptr(9) + offD, DM, DM, (const float*)nullptr, FF, (bf16*)(wl + W_D1), ROW_ID);
        const int kind = l % 3, j = l / 3;
        const float* win; const float* wout; int ldw;
        if (kind == 0) { win = in_ptr(10) + (size_t)j * DM * FOXN; wout = in_ptr(14) + (size_t)j * DM * DM; ldw = FOXN; }
        else if (kind == 1) { win = in_ptr(15) + (size_t)j * DM * NQKV; wout = in_ptr(17) + (size_t)j * DM * DM; ldw = NQKV; }
        else { win = in_ptr(18) + (size_t)j * DM * NQKV; wout = in_ptr(19) + (size_t)j * DM * DM; ldw = NQKV; }
        TR_MAT(win, ldw, NQKV, gm, DM, (bf16*)(wl + W_IN), ROW_ID);
        TR_MAT(wout, DM, DM, (const float*)nullptr, DM, (bf16*)(wl + W_OUT), ROW_ID);
    }
    const float* xin = in_ptr(0);
    for (int m = F.gw; m < SEQ; m += F.ngw) {
        const GAS f32x4* xr = (const GAS f32x4*)(xin + (size_t)m * DM) + lane; GAS f32x4* xo = (GAS f32x4*)(F.X + (size_t)m * DM) + lane;
        GAS v2u* xb = (GAS v2u*)(WSP(bf16, WS_XB) + (size_t)m * DM) + lane; float s = 0.f;
#pragma unroll
        for (int j = 0; j < 8; ++j) { const f32x4 v = xr[64 * j]; xo[64 * j] = v; s += (v.x * v.x + v.y * v.y) + (v.z * v.z + v.w * v.w);
            v2u w; w.x = pk2(v.x, v.y); w.y = pk2(v.z, v.w); xb[64 * j] = w; }
        s = wave_sum(s);
        if (lane == 0) WSP(pg8::u64_t, WS_SS)[m] = (pg8::u64_t)(s * pg8::SS_FIX);
    }
}
__device__ __forceinline__ void p_fgate(Frame& F, int l, const pg8::u64_t* ss) {
    const int j = l / 3; const float* Wf = in_ptr(10) + (size_t)j * DM * FOXN + NQKV; const float* g = in_ptr(2) + l * DM; const float* bf = in_ptr(11) + j * NH;
    const int lane = fresh_tid() & 63;
    for (int rb = F.gw; rb < SEQ / 2; rb += F.ngw) {
        const int t0 = rb * 2; float acc[2][16];
#pragma unroll
        for (int r = 0; r < 2; ++r)
#pragma unroll
            for (int h = 0; h < 16; ++h) acc[r][h] = 0.f;
#pragma unroll 1
        for (int jj = 0; jj < 8; ++jj) { const int kb = 256 * jj + 4 * lane;
            const f32x4 x0 = *(const f32x4*)(F.X + (size_t)t0 * DM + kb), x1 = *(const f32x4*)(F.X + (size_t)(t0 + 1) * DM + kb);
            const f32x4 gv = *(const f32x4*)(g + kb);
#pragma unroll
            for (int i = 0; i < 4; ++i) { const float* wp = Wf + (size_t)(kb + i) * FOXN; const float xg0 = x0[i] * gv[i], xg1 = x1[i] * gv[i];
#pragma unroll
                for (int q = 0; q < 4; ++q) { const f32x4 w = *(const f32x4*)(wp + 4 * q);
#pragma unroll
                    for (int e = 0; e < 4; ++e) { acc[0][4 * q + e] += xg0 * w[e]; acc[1][4 * q + e] += xg1 * w[e]; } } } }
        float mine = 0.f;
#pragma unroll
        for (int r = 0; r < 2; ++r)
#pragma unroll
            for (int h = 0; h < 16; ++h) { const float s = wave_sum(acc[r][h]); if ((lane & 31) == r * 16 + h) mine = s; }
        if (lane < 32) { const int r = lane >> 4, h = lane & 15;
            const float rs = 1.0f / sqrtf((float)ss[t0 + r] * (pg8::SS_UNFIX / DM) + EPS);
            const float u = mine * rs + bf[h];
            WSP(float, WS_LOGF)[(size_t)(t0 + r) * NH + h] = fminf(u, 0.f) - log1pf(expf(-fabsf(u))); }
    }
}
__device__ __forceinline__ void p_qknorm_cumsum(Frame& F, int l) {
    const int j = l / 3; const float* qg = in_ptr(12) + j * HD; const float* kg = in_ptr(13) + j * HD;
    const int tid = fresh_tid(), lane = tid & 63;
    if (blockIdx.x < NH) {
        const int h = blockIdx.x; LAS float* wtot = (LAS float*)F.lds;
        float v[16]; const int t0 = tid * 16; float run = 0.f;
#pragma unroll
        for (int i = 0; i < 16; ++i) { run += WSP(float, WS_LOGF)[(size_t)(t0 + i) * NH + h]; v[i] = run; }
        float inc = run;
#pragma unroll
        for (int o = 1; o < 64; o <<= 1) { const float tv = __shfl_up(inc, o); if (lane >= o) inc += tv; }
        if (lane == 63) wtot[F.wave] = inc;
        __syncthreads();
        float wbase = 0.f;
        for (int w = 0; w < F.wave; ++w) wbase += wtot[w];
        const float excl = wbase + inc - run;
#pragma unroll
        for (int i = 0; i < 16; ++i) WSP(float, WS_CNEG)[(size_t)h * SEQ + t0 + i] = -(excl + v[i]) * LOG2E;
        __syncthreads();
    }
    const int hd0 = (lane & 3) * 32;
    for (int t = F.gw; t < SEQ; t += F.ngw) {
#pragma unroll
        for (int part = 0; part < 2; ++part) {
            bf16* p = WSP(bf16, WS_QKV) + (size_t)t * NQKV + part * DM + lane * 32; const float* gn = part ? kg : qg; const float post = part ? 1.0f : QSCALE;
            v4u w[4]; float x[32]; float s = 0.f;
#pragma unroll
            for (int c = 0; c < 4; ++c) w[c] = *(const v4u*)(p + 8 * c);
#pragma unroll
            for (int c = 0; c < 4; ++c)
#pragma unroll
                for (int e = 0; e < 4; ++e) { x[8 * c + 2 * e] = bf_lo(w[c][e]); x[8 * c + 2 * e + 1] = bf_hi(w[c][e]); }
#pragma unroll
            for (int i = 0; i < 32; ++i) s += x[i] * x[i];
            s += __shfl_xor(s, 1); s += __shfl_xor(s, 2);
            const float rs = post / sqrtf(s * (1.0f / HD) + EPS);
#pragma unroll
            for (int c = 0; c < 4; ++c) { v4u o;
#pragma unroll
                for (int e = 0; e < 4; ++e) o[e] = pk2(x[8 * c + 2 * e] * rs * gn[hd0 + 8 * c + 2 * e], x[8 * c + 2 * e + 1] * rs * gn[hd0 + 8 * c + 2 * e + 1]);
                *(v4u*)(p + 8 * c) = o; }
        }
    }
}
__device__ __forceinline__ void p_conv(Frame& F, int l) {
    const float* ck = in_ptr(16) + (size_t)(l / 3) * 3 * DM; const int lane = fresh_tid() & 63;
    const int nthr = F.ngw * 64;
    for (int idx = F.gw * 64 + lane; idx < SEQ * (DM / 8); idx += nthr) {
        const int t = idx >> 8, c = (idx & 255) * 8;
        float in0[8], in1[8], in2[8];
#pragma unroll
        for (int d = 0; d < 3; ++d) { float* dst = d == 0 ? in0 : (d == 1 ? in1 : in2);
            if (t - d >= 0) { const bf16* r = WSP(bf16, WS_QKV) + (size_t)(t - d) * NQKV + c; const v4u cg = *(const v4u*)(r + DM), uu = *(const v4u*)(r + 2 * DM);
#pragma unroll
                for (int e = 0; e < 4; ++e) { dst[2 * e] = bf_lo(cg[e]) * bf_lo(uu[e]); dst[2 * e + 1] = bf_hi(cg[e]) * bf_hi(uu[e]); } }
            else {
#pragma unroll
                for (int e = 0; e < 8; ++e) dst[e] = 0.f; } }
        const v4u bg = *(const v4u*)(WSP(bf16, WS_QKV) + (size_t)t * NQKV + c); float y[8];
#pragma unroll
        for (int e = 0; e < 8; ++e) { const float cv = ck[c + e] * in2[e] + ck[DM + c + e] * in1[e] + ck[2 * DM + c + e] * in0[e];
            const float b = (e & 1) ? bf_hi(bg[e >> 1]) : bf_lo(bg[e >> 1]); y[e] = b * cv; }
        v4u o; o.x = pk2(y[0], y[1]); o.y = pk2(y[2], y[3]); o.z = pk2(y[4], y[5]); o.w = pk2(y[6], y[7]);
        *(v4u*)(WSP(bf16, WS_OB) + (size_t)t * DM + c) = o;
    }
}
template <int KIND>
__device__ __forceinline__ void p_attn_naive(Frame& F) {
    const int lane = fresh_tid() & 63;
    for (int p = F.gw; p < SEQ * NH; p += F.ngw) {
        const int h = p & 15, t = p >> 4;
        const bf16* Qr = WSP(bf16, WS_QKV) + (size_t)t * NQKV + h * HD; const bf16* Kh = WSP(bf16, WS_QKV) + DM + h * HD; const bf16* Vh = WSP(bf16, WS_QKV) + 2 * DM + h * HD + 2 * lane;
        LAS float* q = (LAS float*)(F.lds + F.wave * 1024);
        { const unsigned w = *(const unsigned*)(Qr + 2 * lane); asm volatile("" ::: "memory"); q[2 * lane] = bf_lo(w); q[2 * lane + 1] = bf_hi(w); LDS_WAIT(); asm volatile("" ::: "memory"); }
        float o0 = 0.f, o1 = 0.f;
        if (KIND == 0) {
            const float* cn = WSP(float, WS_CNEG) + (size_t)h * SEQ; const float cnt = cn[t];
            float m = -1e30f, lsum = 0.f; const int nt = t / 64 + 1;
            for (int jt = 0; jt < nt; ++jt) { asm volatile("" ::: "memory"); const int s0 = jt * 64, s = s0 + lane; const bf16* kr = Kh + (size_t)s * NQKV; float dot = 0.f;
#pragma unroll
                for (int c = 0; c < 16; ++c) { const v4u w = *(const v4u*)(kr + 8 * c);
#pragma unroll
                    for (int e = 0; e < 4; ++e) dot += q[8 * c + 2 * e] * bf_lo(w[e]) + q[8 * c + 2 * e + 1] * bf_hi(w[e]); }
                float sc = dot + (cn[s] - cnt); if (s > t) sc = -__builtin_inff();
                const float mn = fmaxf(m, wave_max(sc)); const float pr = exp2f(sc - mn), al = exp2f(m - mn);
                lsum = lsum * al + wave_sum(pr); o0 *= al; o1 *= al; m = mn;
#pragma unroll 8
                for (int jj = 0; jj < 64; ++jj) { const float pj = __int_as_float(__builtin_amdgcn_readlane(__float_as_int(pr), jj));
                    const unsigned vv = *(const unsigned*)(Vh + (size_t)(s0 + jj) * NQKV); o0 += pj * bf_lo(vv); o1 += pj * bf_hi(vv); } }
            const float il = 1.0f / lsum; o0 *= il; o1 *= il;
        } else {
            float R = 0.f;
            for (int jt = (t - 1) >> 6; jt >= 0 && t > 0 && R > -200.f; --jt) {     asm volatile("" ::: "memory"); const int s0 = jt * 64, s = s0 + lane; const bf16* kr = Kh + (size_t)s * NQKV; float z = 0.f;
#pragma unroll
                for (int c = 0; c < 16; ++c) { const v4u w = *(const v4u*)(kr + 8 * c);
#pragma unroll
                    for (int e = 0; e < 4; ++e) z += q[8 * c + 2 * e] * bf_lo(w[e]) + q[8 * c + 2 * e + 1] * bf_hi(w[e]); }
                const bool valid = s < t;
                const float ls = fminf(z, 0.f) - log2f(1.0f + exp2f(-fabsf(z)));
                const float lom = valid ? ls - z : 0.f;
                float inc = lom;
#pragma unroll
                for (int o = 1; o < 64; o <<= 1) { const float tv = __shfl_down(inc, o); if (lane + o < 64) inc += tv; }
                const float a = valid ? exp2f(ls + R + (inc - lom)) : 0.f;
                R += __int_as_float(__builtin_amdgcn_readlane(__float_as_int(inc), 0));
#pragma unroll 8
                for (int jj = 0; jj < 64; ++jj) { const float pj = __int_as_float(__builtin_amdgcn_readlane(__float_as_int(a), jj));
                    const unsigned vv = *(const unsigned*)(Vh + (size_t)(s0 + jj) * NQKV); o0 += pj * bf_lo(vv); o1 += pj * bf_hi(vv); } }
        }
        *(unsigned*)(WSP(bf16, WS_OB) + (size_t)t * DM + h * HD + 2 * lane) = pk2(o0, o1);
    }
}

struct Args { const float* in[20]; float* out; unsigned char* ws; int ph_lo, ph_hi; };
__global__ void __launch_bounds__(NWAVES * 64, 2) mk_fwd(Args args) {
    extern __shared__ __attribute__((aligned(16))) unsigned char lds[];
    Frame F;
    F.lds = (LAS unsigned char*)lds;
    F.wave = __builtin_amdgcn_readfirstlane((int)threadIdx.x >> 6);
    F.gw = blockIdx.x * NWAVES + F.wave; F.ngw = gridDim.x * NWAVES;
    F.X = args.out; F.ws = args.ws;
    for (int u = threadIdx.x; u < (LDS_BYTES - LDSCTL_OFF) / 4; u += NWAVES * 64) ((LAS unsigned*)(F.lds + LDSCTL_OFF))[u] = 0u;
    __syncthreads();
    const int lo = args.ph_lo, hi = args.ph_hi;
    unsigned* barw = (unsigned*)(args.ws + WS_CTL) + CW_BAR;
    XcdBarrier bar; bar.bar = barw; bar.x = 0; bar.st = nullptr;
    if (hi - lo > 1) bar = xcd_barrier_post(barw, (volatile LAS unsigned*)(F.lds + MISC_OFF) + 8);
    const int G = gridDim.x, bid = blockIdx.x;
    int ph = 0;
#define RUN() (lo <= ph && ph < hi)
#define SEAM() do { if (lo <= ph && ph + 1 < hi) xcd_barrier(bar); ++ph; } while (0)

    if (RUN()) { _Pragma("unroll 1") for (int rep = 0; rep < 1 + ((MK_PROBE >> 0) & 1); ++rep) p_prologue(F); }
    SEAM();
    for (int f = 0; f < 2 * DEPTH; ++f) {
        const int l = f >> 1, sub = f & 1, nidx = 3 * l + (sub ? 2 : 0);
        unsigned char* wl = args.ws + WS_W + (size_t)l * W_LAYER;
        if (RUN()) {
            pg8::Gemm g{WSP(bf16, WS_XB), (const bf16*)(wl + (sub ? W_GU1 : W_GU0)), SEQ, 2 * FF, DM}; pg8::StaticOrder S; S.init(SEQ, 2 * FF, G, bid);
            pg8::EpiSwiglu E{WSP(bf16, WS_ACT), FF, WSP(pg8::u64_t, WS_SS) + (size_t)nidx * SEQ};
            _Pragma("unroll 1") for (int rep = 0; rep < 1 + ((MK_PROBE >> 1) & 1); ++rep) pg8::gemm_phase<pg8::EpiSwiglu, pg8::StaticOrder, true, true>(F.lds, g, S, E);
        }
        SEAM();
        if (RUN()) {
            pg8::Gemm g{WSP(bf16, WS_ACT), (const bf16*)(wl + (sub ? W_D1 : W_D0)), SEQ, DM, FF}; pg8::StaticOrder S; S.init(SEQ, DM, G, bid);
            pg8::EpiResid E{F.X, WSP(bf16, WS_XB), WSP(pg8::u64_t, WS_SS) + (size_t)(nidx + 1) * SEQ, 0.5f};
#if (MK_PROBE >> 4) & 1
            { pg8::EpiResid E0{F.X, WSP(bf16, WS_XB), WSP(pg8::u64_t, WS_SS) + (size_t)13 * SEQ, 0.0f}; pg8::gemm_phase<pg8::EpiResid, pg8::StaticOrder, true, true>(F.lds, g, S, E0); }
#endif
            pg8::gemm_phase<pg8::EpiResid, pg8::StaticOrder, true, true>(F.lds, g, S, E);
        }
        SEAM();
        if (sub == 0) {
            const int kind = l % 3; const pg8::u64_t* ssm = WSP(pg8::u64_t, WS_SS) + (size_t)(3 * l + 1) * SEQ;
            if (RUN()) {
                pg8::Gemm g{WSP(bf16, WS_XB), (const bf16*)(wl + W_IN), SEQ, NQKV, DM}; pg8::StaticOrder S; S.init(SEQ, NQKV, G, bid);
                pg8::EpiQKV E{WSP(bf16, WS_QKV), NQKV, ssm, QSCALE, kind == 2 ? DM / 256 : 0};
                _Pragma("unroll 1") for (int rep = 0; rep < 1 + ((MK_PROBE >> 3) & 1); ++rep) pg8::gemm_phase<pg8::EpiQKV, pg8::StaticOrder, true, true>(F.lds, g, S, E);
                if (kind == 0) p_fgate(F, l, ssm);
            }
            SEAM();
            if (kind == 0) {
                if (RUN()) p_qknorm_cumsum(F, l);
                SEAM();
#if MK_NAIVE_ATTN
                if (RUN()) p_attn_naive<0>(F);
#else
                if (RUN()) { _Pragma("unroll 1") for (int rep = 0; rep < 1 + ((MK_PROBE >> 2) & 1); ++rep) att::attn_phase<0>((char*)lds, WSP(bf16, WS_QKV), WSP(bf16, WS_OB), WSP(float, WS_CNEG)); }
#endif
                SEAM();
            } else if (kind == 1) {
                if (RUN()) p_conv(F, l);
                SEAM();
            } else {
#if MK_NAIVE_ATTN
                if (RUN()) p_attn_naive<2>(F);
#else
                if (RUN()) { _Pragma("unroll 1") for (int rep = 0; rep < 1 + ((MK_PROBE >> 2) & 1); ++rep) att::attn_phase<2>((char*)lds, WSP(bf16, WS_QKV), WSP(bf16, WS_OB), WSP(float, WS_CNEG)); }
#endif
                SEAM();
            }
            if (RUN()) {
                pg8::Gemm g{WSP(bf16, WS_OB), (const bf16*)(wl + W_OUT), SEQ, DM, DM}; pg8::StaticOrder S; S.init(SEQ, DM, G, bid);
                pg8::EpiResid E{F.X, WSP(bf16, WS_XB), WSP(pg8::u64_t, WS_SS) + (size_t)(3 * l + 2) * SEQ, 1.0f};
                pg8::gemm_phase<pg8::EpiResid, pg8::StaticOrder, true, true>(F.lds, g, S, E);
            }
            SEAM();
        }
    }
#undef RUN
#undef SEAM
}

extern "C" void kernel_launch(void* const* d_in, const int* in_sizes, int n_in, void* d_out, int out_size, void* d_ws, size_t ws_size, hipStream_t stream) {
    static int grid = 0;
    if (grid == 0) {
        if (n_in != 20 || in_sizes[0] != SEQ * DM || out_size != SEQ * DM || ws_size < WS_END) {
            fprintf(stderr, "kernel_launch: unexpected shapes (n_in %d, in0 %d, out %d, ws %zu; need ws >= %zu); nothing launched\n", n_in, n_in > 0 ? in_sizes[0] : -1, out_size, ws_size, (size_t)WS_END); grid = -1; return; }
        int dev = 0, cus = 0, per_cu = 0;
        if (hipGetDevice(&dev) != hipSuccess || hipDeviceGetAttribute(&cus, hipDeviceAttributeMultiprocessorCount, dev) != hipSuccess) { grid = -1; return; }
        if (hipFuncSetAttribute((const void*)mk_fwd, hipFuncAttributeMaxDynamicSharedMemorySize, LDS_BYTES) != hipSuccess) { fprintf(stderr, "kernel_launch: hipFuncSetAttribute failed\n"); grid = -1; return; }
        if (hipOccupancyMaxActiveBlocksPerMultiprocessor(&per_cu, (const void*)mk_fwd, NWAVES * 64, LDS_BYTES) != hipSuccess || per_cu < 1)
            fprintf(stderr, "kernel_launch: note: occupancy query reports %d workgroups per CU\n", per_cu);
        (void)hipGetLastError();
        grid = cus;
    }
    if (grid < 0) return;
    if (hipMemsetAsync((char*)d_ws + WS_CTL, 0, CTL_ZERO_BYTES, stream) != hipSuccess) { fprintf(stderr, "kernel_launch: memset failed\n"); return; }
    Args a{};
    for (int i = 0; i < 20; ++i) a.in[i] = (const float*)d_in[i];
    a.out = (float*)d_out; a.ws = (unsigned char*)d_ws;
#if MK_ONE_LAUNCH
    a.ph_lo = 0; a.ph_hi = N_PHASES;
    hipLaunchKernelGGL(mk_fwd, dim3(grid), dim3(NWAVES * 64), LDS_BYTES, stream, a);
#else
    for (int p = 0; p < N_PHASES; ++p) { a.ph_lo = p; a.ph_hi = p + 1;
        hipLaunchKernelGGL(mk_fwd, dim3(grid), dim3(NWAVES * 64), LDS_BYTES, stream, a); }
#endif
    const hipError_t le = hipPeekAtLastError();
    if (le != hipSuccess) fprintf(stderr, "kernel_launch: launch failed: %s\n", hipGetErrorName(le));
}
```

```cpp
#include <hip/hip_runtime.h>
#include <cstdio>
#include <cstdint>
#ifndef MK_ONE_LAUNCH
#define MK_ONE_LAUNCH 1
#endif
#ifndef MK_NAIVE_ATTN
#define MK_NAIVE_ATTN 0
#endif
#ifndef MK_PROBE
#define MK_PROBE 0
#endif
#ifndef MK_RELAUNCH
#define MK_RELAUNCH -1
#define MK_RELAUNCH_N 1
#define MK_RELAUNCH_SCHED 0
#define MK_RELAUNCH_SPAN 1
#endif
#ifndef MK_STAMP
#define MK_STAMP 0
#endif
__device__ __forceinline__ int mk_lane_() { unsigned z = 0u; asm volatile("" : "+v"(z)); return (int)__builtin_amdgcn_mbcnt_hi(~0u, __builtin_amdgcn_mbcnt_lo(~0u, z)); }
#define MK_LANE() mk_lane_()
#define MK_TID(wave) ((int)(wave) * 64 + MK_LANE())
namespace pg8 {
#define PG8_LAS __attribute__((address_space(3)))
typedef unsigned short bf16_t;
typedef short bf16x8 __attribute__((ext_vector_type(8)));
typedef float f32x4 __attribute__((ext_vector_type(4)));
typedef unsigned u32x4 __attribute__((ext_vector_type(4)));
constexpr int BM = 256, BK = 64, HALF = 128, HTB = HALF * BK * 2  , STAGE_BYTES = 8 * HTB, NXCD = 8, WGM = 8;

__host__ __device__ __forceinline__ int lds_byte(int r, int c) { const int st = (r >> 4) * 2 + (c >> 5), rr = r & 15, cc = c & 31, ob = rr * 64 + cc * 2; return st * 1024 + (ob ^ (((ob >> 9) & 1) << 5)); }
__host__ __device__ __forceinline__ void stage_rc(int b, int& R, int& C) { const int st = b / 1024, sb = b % 1024, swz = sb ^ (((sb >> 9) & 1) << 5); R = (st >> 1) * 16 + swz / 64; C = (st & 1) * 32 + (swz % 64) / 2; }
__host__ __device__ __forceinline__ int perm32(int rho) { const int n = rho >> 4, i = rho & 15; return 8 * (i >> 2) + 4 * n + (i & 3); }

struct Unit { int pm, pn; };
struct Gemm { const bf16_t* A; const bf16_t* Bt; int M, N, K; };

struct StaticOrder {
    int nM, nN, nwg, G, c, i0, ni;
    __host__ __device__ void init(int M, int N, int G_, int c_) { nM = M / BM; nN = N / BM; nwg = nM * nN; G = G_; c = c_; i0 = 0; ni = 1 << 20; }
    __host__ __device__ bool next(int i, Unit& u) const {
        if (i >= ni) return false;
        const long L = (long)(i + i0) * G + c; if (L >= nwg) return false;
        int wgid = (int)L; { const int q = nwg / NXCD, r = nwg % NXCD, xcd = wgid % NXCD, off = wgid / NXCD; wgid = (xcd < r ? xcd * (q + 1) : r * (q + 1) + (xcd - r) * q) + off; }
        const int nig = WGM * nN, gid = wgid / nig, fm = gid * WGM, gsz = (nM - fm) < WGM ? (nM - fm) : WGM;
        u.pm = fm + ((wgid % nig) % gsz); u.pn = (wgid % nig) / gsz; return true;
    }
    __device__ __forceinline__ void a_ready(const Unit&) const {}
    __device__ __forceinline__ void done(const Unit&) const {}
};


__device__ __forceinline__ unsigned cvt_pk_bf16(float lo, float hi) { unsigned r; asm volatile("v_cvt_pk_bf16_f32 %0, %1, %2" : "=v"(r) : "v"(lo), "v"(hi)); return r; }
constexpr float NORM_EPS = 1e-6f, INV_D = 1.0f / 2048.0f, SS_FIX = 16777216.0f, SS_UNFIX = 1.0f / 16777216.0f;
typedef unsigned long long u64_t;
constexpr int SSL_OFF = 131072 + 8192;
__device__ __forceinline__ void ss_prefetch(PG8_LAS unsigned char* lds, const u64_t* ss, int pm, int par, int tid, int wid) {
    __builtin_amdgcn_global_load_lds((const unsigned*)(ss + (size_t)pm * BM) + tid, (PG8_LAS unsigned*)(lds + SSL_OFF + par * 2048 + wid * 256), 4, 0, 0);
}
__device__ __forceinline__ float ssl_rstd(const PG8_LAS unsigned char* lds, int par, int lrow) { return __builtin_amdgcn_rsqf((float)*(const PG8_LAS u64_t*)(lds + SSL_OFF + par * 2048 + lrow * 8) * (SS_UNFIX * INV_D) + NORM_EPS); }
__device__ __forceinline__ float ss_rstd(const u64_t* ss, int row) { return __builtin_amdgcn_rsqf((float)ss[row] * (SS_UNFIX * INV_D) + NORM_EPS); }
__device__ __forceinline__ float silu_mul(float g, float u) {
    const float e = __builtin_amdgcn_exp2f(g * -1.4426950408889634f);
    return g * u * __builtin_amdgcn_rcpf(1.0f + e);
}
struct EpiSwiglu {
    static constexpr bool PERM = true, AFTER_DRAIN = false;
    bf16_t* O; int ldc; const u64_t* ss; PG8_LAS unsigned char* lds;
    __device__ __forceinline__ void pre(PG8_LAS unsigned char*, const Unit& u, int par, int tid, int wid) const { if (ss) ss_prefetch(lds, ss, u.pm, par, tid, wid); }
    __device__ __forceinline__ void operator()(const f32x4 (&acc)[2][2][4][2], const Unit& u, int wr, int wc, int fr, int fq, int par) const {
        const int row0 = u.pm * BM + wr * 64 + fr, col0 = u.pn * HALF + wc * 32 + 8 * fq;
#pragma unroll
        for (int ai = 0; ai < 2; ++ai)
#pragma unroll
            for (int m = 0; m < 4; ++m) { const int row = row0 + ai * HALF + m * 16;
                const float rs = ss ? ssl_rstd(lds, par, row - u.pm * BM) : 1.0f;
                const f32x4 g0 = acc[ai][0][m][0] * rs, g1 = acc[ai][0][m][1] * rs, u0 = acc[ai][1][m][0] * rs, u1 = acc[ai][1][m][1] * rs;
                u32x4 w; w.x = cvt_pk_bf16(silu_mul(g0[0], u0[0]), silu_mul(g0[1], u0[1])); w.y = cvt_pk_bf16(silu_mul(g0[2], u0[2]), silu_mul(g0[3], u0[3]));
                w.z = cvt_pk_bf16(silu_mul(g1[0], u1[0]), silu_mul(g1[1], u1[1])); w.w = cvt_pk_bf16(silu_mul(g1[2], u1[2]), silu_mul(g1[3], u1[3]));
                *(u32x4*)(O + (size_t)row * ldc + col0) = w; }
    }
};
struct EpiQKV {
    static constexpr bool PERM = true, AFTER_DRAIN = false;
    bf16_t* O; int ldc; const u64_t* ss; float qscale; int qtiles; const float* qg; const float* kg; PG8_LAS float* scr;
    __device__ __forceinline__ void pre(PG8_LAS unsigned char* lds, const Unit& u, int par, int tid, int wid) const { ss_prefetch(lds, ss, u.pm, par, tid, wid); }
    __device__ __forceinline__ void operator()(const f32x4 (&acc)[2][2][4][2], const Unit& u, int wr, int wc, int fr, int fq, int par) const {
        const int row0 = u.pm * BM + wr * 64 + fr, col0 = u.pn * BM + wc * 32 + 8 * fq;
        const float sc = (u.pn < qtiles) ? qscale : 1.0f;
        float rsv[2][4];
#pragma unroll
        for (int ai = 0; ai < 2; ++ai)
#pragma unroll
            for (int m = 0; m < 4; ++m) rsv[ai][m] = ssl_rstd((const PG8_LAS unsigned char*)scr - 131072, par, wr * 64 + fr + ai * HALF + m * 16);
        const bool hn = (qg != nullptr) && (u.pn < 16);
        float hs[2][4][2]; f32x4 ga = {1.f, 1.f, 1.f, 1.f}, gb = {1.f, 1.f, 1.f, 1.f};
        if (hn) {
            const float* gn = (u.pn < 8) ? qg : kg; const float post = (u.pn < 8) ? qscale : 1.0f;
            ga = *(const f32x4*)(gn + wc * 32 + 8 * fq); gb = *(const f32x4*)(gn + wc * 32 + 8 * fq + 4);
#pragma unroll
            for (int ai = 0; ai < 2; ++ai)
#pragma unroll
                for (int m = 0; m < 4; ++m)
#pragma unroll
                    for (int bj = 0; bj < 2; ++bj) { const f32x4 v0 = acc[ai][bj][m][0] * rsv[ai][m], v1 = acc[ai][bj][m][1] * rsv[ai][m];
                        float s = ((v0[0] * v0[0] + v0[1] * v0[1]) + (v0[2] * v0[2] + v0[3] * v0[3])) + ((v1[0] * v1[0] + v1[1] * v1[1]) + (v1[2] * v1[2] + v1[3] * v1[3]));
                        s += __shfl_xor(s, 16); s += __shfl_xor(s, 32);
                        if (fq == 0) scr[((ai * HALF + wr * 64 + m * 16 + fr) * 2 + bj) * 4 + wc] = s; }
            asm volatile("s_waitcnt lgkmcnt(0)" ::: "memory"); __builtin_amdgcn_s_barrier(); asm volatile("" ::: "memory");
#pragma unroll
            for (int ai = 0; ai < 2; ++ai)
#pragma unroll
                for (int m = 0; m < 4; ++m)
#pragma unroll
                    for (int bj = 0; bj < 2; ++bj) { const f32x4 p = *(const PG8_LAS f32x4*)(scr + ((ai * HALF + wr * 64 + m * 16 + fr) * 2 + bj) * 4);
                        hs[ai][m][bj] = post * __builtin_amdgcn_rsqf(((p[0] + p[1]) + (p[2] + p[3])) * (1.0f / 128.0f) + NORM_EPS); }
        } else {
#pragma unroll
            for (int ai = 0; ai < 2; ++ai)
#pragma unroll
                for (int m = 0; m < 4; ++m) { hs[ai][m][0] = sc; hs[ai][m][1] = sc; }
        }
#pragma unroll
        for (int ai = 0; ai < 2; ++ai)
#pragma unroll
            for (int m = 0; m < 4; ++m) { const int row = row0 + ai * HALF + m * 16;
#pragma unroll
                for (int bj = 0; bj < 2; ++bj) { const float rs = rsv[ai][m] * hs[ai][m][bj]; const f32x4 v0 = acc[ai][bj][m][0] * rs * ga, v1 = acc[ai][bj][m][1] * rs * gb;
                    u32x4 w; w.x = cvt_pk_bf16(v0[0], v0[1]); w.y = cvt_pk_bf16(v0[2], v0[3]); w.z = cvt_pk_bf16(v1[0], v1[1]); w.w = cvt_pk_bf16(v1[2], v1[3]);
                    *(u32x4*)(O + (size_t)row * ldc + col0 + bj * HALF) = w; } }
    }
};
struct EpiResid {
    static constexpr bool PERM = true, AFTER_DRAIN = false;
    float* OUTF; bf16_t* XB; u64_t* ss_out; float alpha;
    __device__ __forceinline__ void pre(PG8_LAS unsigned char*, const Unit&, int, int, int) const {}
    __device__ __forceinline__ void operator()(const f32x4 (&acc)[2][2][4][2], const Unit& u, int wr, int wc, int fr, int fq, int) const {
        const int row0 = u.pm * BM + wr * 64 + fr, col0 = u.pn * BM + wc * 32 + 8 * fq;
#pragma unroll
        for (int ai = 0; ai < 2; ++ai)
#pragma unroll
            for (int m = 0; m < 4; ++m) { const int row = row0 + ai * HALF + m * 16; const size_t off = (size_t)row * 2048 + col0; float sq = 0.f;
                u32x4 xo[2];
#pragma unroll
                for (int bj = 0; bj < 2; ++bj) xo[bj] = *(const u32x4*)(XB + off + bj * HALF);
#pragma unroll
                for (int bj = 0; bj < 2; ++bj) { f32x4 x0, x1;
#pragma unroll
                    for (int e = 0; e < 2; ++e) { x0[2 * e] = __uint_as_float(xo[bj][e] << 16); x0[2 * e + 1] = __uint_as_float(xo[bj][e] & 0xffff0000u);
                                                  x1[2 * e] = __uint_as_float(xo[bj][2 + e] << 16); x1[2 * e + 1] = __uint_as_float(xo[bj][2 + e] & 0xffff0000u); }
                    x0 = x0 + acc[ai][bj][m][0] * alpha; x1 = x1 + acc[ai][bj][m][1] * alpha;
                    sq += ((x0[0] * x0[0] + x0[1] * x0[1]) + (x0[2] * x0[2] + x0[3] * x0[3])) + ((x1[0] * x1[0] + x1[1] * x1[1]) + (x1[2] * x1[2] + x1[3] * x1[3]));
                    u32x4 w; w.x = cvt_pk_bf16(x0[0], x0[1]); w.y = cvt_pk_bf16(x0[2], x0[3]); w.z = cvt_pk_bf16(x1[0], x1[1]); w.w = cvt_pk_bf16(x1[2], x1[3]);
                    *(u32x4*)(XB + off + bj * HALF) = w;
                    if (OUTF) { *(f32x4*)(OUTF + off + bj * HALF) = x0; *(f32x4*)(OUTF + off + bj * HALF + 4) = x1; } }
                sq += __shfl_xor(sq, 16); sq += __shfl_xor(sq, 32);
                if (fq == 0) __hip_atomic_fetch_add(ss_out + row, (u64_t)(sq * SS_FIX), __ATOMIC_RELAXED, __HIP_MEMORY_SCOPE_AGENT); }
    }
};
template <class Epi, class Sched, bool ALIGN_EPI = false, bool SP2 = false>
__device__ __forceinline__ void gemm_phase(PG8_LAS unsigned char* lds, const Gemm g, const Sched& S, const Epi& E, const int wave_id) {
    int tid_ = MK_TID(wave_id); asm volatile("" : "+v"(tid_));
    const int tid = tid_, wid = __builtin_amdgcn_readfirstlane(tid >> 6), lane = tid & 63, wr = wid >> 2, wc = wid & 3, fr = lane & 15, fq = lane >> 4;
    const int K = g.K, nt = K / BK;
    unsigned voffA[2], voffB[2];
#pragma unroll
    for (int i = 0; i < 2; ++i) { int R, C; stage_rc(tid * 16 + i * 8192, R, C); const int Rb = Epi::PERM ? ((R & ~31) + perm32(R & 31)) : R;
        voffA[i] = (unsigned)(R * K + C) * 2u; voffB[i] = (unsigned)(Rb * K + C) * 2u; }
    const size_t kstep = (size_t)(BK * 2);
    const size_t hstep = (size_t)HALF * K * 2;
    const size_t tstep = 2 * hstep;
    const unsigned ldsw = (unsigned)wid * 1024u;
    const int aoff = lds_byte(wr * 64 + fr, fq * 8), boff = lds_byte(wc * 32 + fr, fq * 8);
#define PG8_SA(b, h) (((b) * 2 + (h)) * HTB)
#define PG8_SB(b, h) ((4 + (b) * 2 + (h)) * HTB)
#define PG8_STAGE(bufoff, gbase, voff) do { _Pragma("unroll") for (int _i = 0; _i < 2; ++_i) \
        __builtin_amdgcn_global_load_lds((const unsigned*)((const char*)(gbase) + (voff)[_i]), (PG8_LAS unsigned*)(lds + (bufoff) + ldsw + _i * 8192), 16, 0, 0); } while (0)
#define PG8_LDA(dst, b, h) do { _Pragma("unroll") for (int m = 0; m < 4; ++m) _Pragma("unroll") for (int k = 0; k < 2; ++k) dst[m][k] = *(const PG8_LAS bf16x8*)(lds + PG8_SA(b, h) + aoff + m * 2048 + k * 1024); } while (0)
#define PG8_LDB(dst, b, h) do { _Pragma("unroll") for (int n = 0; n < 2; ++n) _Pragma("unroll") for (int k = 0; k < 2; ++k) dst[n][k] = *(const PG8_LAS bf16x8*)(lds + PG8_SB(b, h) + boff + n * 2048 + k * 1024); } while (0)
#define PG8_MMA(ai, bj, At, Bt) do { __builtin_amdgcn_s_setprio(1); _Pragma("unroll") for (int m = 0; m < 4; ++m) _Pragma("unroll") for (int n = 0; n < 2; ++n) _Pragma("unroll") for (int k = 0; k < 2; ++k) \
        acc[ai][bj][m][n] = __builtin_amdgcn_mfma_f32_16x16x32_bf16(Bt[n][k], At[m][k], acc[ai][bj][m][n], 0, 0, 0); __builtin_amdgcn_s_setprio(0); } while (0)
#define PG8_WAIT_V(n) asm volatile("s_waitcnt vmcnt(" #n ")" ::: "memory")
#define PG8_WAIT_L(n) asm volatile("s_waitcnt lgkmcnt(" #n ")" ::: "memory")
#define PG8_BAR __builtin_amdgcn_s_barrier()
#define PG8_SCHED __builtin_amdgcn_sched_barrier(0)
    Unit cur, nxt; int ui = 0;
    if (!S.next(0, cur)) return;
    f32x4 acc[2][2][4][2];
#pragma unroll
    for (int a = 0; a < 2; ++a)
#pragma unroll
        for (int b = 0; b < 2; ++b)
#pragma unroll
            for (int m = 0; m < 4; ++m)
#pragma unroll
                for (int n = 0; n < 2; ++n) acc[a][b][m][n] = (f32x4){0.f, 0.f, 0.f, 0.f};
    bf16x8 At[4][2], B0[2][2], B1[2][2];
    const char* cA = (const char*)g.A + (size_t)cur.pm * tstep; const char* cB = (const char*)g.Bt + (size_t)cur.pn * tstep;
    S.a_ready(cur);
    E.pre(lds, cur, 0, tid, wid);
    if constexpr (SP2) {
        PG8_STAGE(PG8_SB(0, 0), cB, voffB); PG8_STAGE(PG8_SB(0, 1), cB + hstep, voffB); PG8_STAGE(PG8_SA(0, 0), cA, voffA); PG8_STAGE(PG8_SA(0, 1), cA + hstep, voffA);
        if (wr == 1) PG8_BAR;
        PG8_WAIT_V(2); PG8_BAR;
        PG8_STAGE(PG8_SB(1, 0), cB + kstep, voffB); PG8_STAGE(PG8_SA(1, 0), cA + kstep, voffA); PG8_STAGE(PG8_SB(1, 1), cB + hstep + kstep, voffB);
        PG8_WAIT_V(6); PG8_BAR;
    } else {
        PG8_STAGE(PG8_SB(0, 0), cB, voffB); PG8_STAGE(PG8_SA(0, 0), cA, voffA); PG8_STAGE(PG8_SB(0, 1), cB + hstep, voffB); PG8_STAGE(PG8_SA(0, 1), cA + hstep, voffA);
        if (wr == 1) PG8_BAR;
        PG8_WAIT_V(4); PG8_BAR;
        PG8_STAGE(PG8_SB(1, 0), cB + kstep, voffB); PG8_STAGE(PG8_SA(1, 0), cA + kstep, voffA); PG8_STAGE(PG8_SB(1, 1), cB + hstep + kstep, voffB);
        PG8_WAIT_V(6); PG8_BAR;
    }
    for (;;) {
        const bool has_next = S.next(ui + 1, nxt);
        const char* nA = has_next ? (const char*)g.A + (size_t)nxt.pm * tstep : cA; const char* nB = has_next ? (const char*)g.Bt + (size_t)nxt.pn * tstep : cB;
        for (int t = 0; t < nt; t += 2) {
            const bool last = (t == nt - 2);
            const char* a1 = cA + (size_t)(t + 1) * kstep;
            const char* a2 = last ? nA : cA + (size_t)(t + 2) * kstep; const char* b2 = last ? nB : cB + (size_t)(t + 2) * kstep;
            const char* a3 = a2 + kstep; const char* b3 = b2 + kstep;
            if (last && has_next) S.a_ready(nxt);
            if constexpr (SP2) {
            PG8_LDB(B0, 0, 0); PG8_LDB(B1, 0, 1); PG8_SCHED; PG8_LDA(At, 0, 0); PG8_STAGE(PG8_SA(1, 1), a1 + hstep, voffA);
            PG8_WAIT_V(8); PG8_WAIT_L(0); PG8_BAR; PG8_MMA(0, 0, At, B0); PG8_MMA(0, 1, At, B1); PG8_BAR; PG8_SCHED;
            PG8_LDA(At, 0, 1); PG8_STAGE(PG8_SB(0, 0), b2, voffB); PG8_STAGE(PG8_SB(0, 1), b2 + hstep, voffB); PG8_STAGE(PG8_SA(0, 0), a2, voffA);
            PG8_WAIT_V(8); PG8_WAIT_L(0); PG8_BAR; PG8_MMA(1, 0, At, B0); PG8_MMA(1, 1, At, B1); PG8_BAR; PG8_SCHED;
            PG8_LDB(B0, 1, 0); PG8_LDB(B1, 1, 1); PG8_SCHED; PG8_LDA(At, 1, 0); PG8_STAGE(PG8_SA(0, 1), a2 + hstep, voffA);
            PG8_WAIT_V(8); PG8_WAIT_L(0); PG8_BAR; PG8_MMA(0, 0, At, B0); PG8_MMA(0, 1, At, B1); PG8_BAR; PG8_SCHED;
            PG8_LDA(At, 1, 1); PG8_STAGE(PG8_SB(1, 0), b3, voffB); PG8_STAGE(PG8_SB(1, 1), b3 + hstep, voffB); PG8_STAGE(PG8_SA(1, 0), a3, voffA);
            PG8_WAIT_V(8); PG8_WAIT_L(0); PG8_BAR; PG8_MMA(1, 0, At, B0); PG8_MMA(1, 1, At, B1); PG8_BAR; PG8_SCHED;
            } else {
            PG8_LDB(B0, 0, 0); PG8_SCHED; PG8_LDA(At, 0, 0); PG8_STAGE(PG8_SA(1, 1), a1 + hstep, voffA);
            PG8_WAIT_L(8); PG8_BAR; PG8_WAIT_L(0); PG8_MMA(0, 0, At, B0); PG8_BAR; PG8_SCHED;
            PG8_LDB(B1, 0, 1); PG8_STAGE(PG8_SB(0, 0), b2, voffB);
            PG8_BAR; PG8_WAIT_L(0); PG8_MMA(0, 1, At, B1); PG8_BAR;
            PG8_LDA(At, 0, 1); PG8_STAGE(PG8_SA(0, 0), a2, voffA);
            PG8_BAR; PG8_WAIT_L(0); PG8_MMA(1, 0, At, B0); PG8_BAR; PG8_SCHED;
            PG8_STAGE(PG8_SB(0, 1), b2 + hstep, voffB);
            PG8_WAIT_V(6); PG8_BAR; PG8_MMA(1, 1, At, B1); PG8_BAR;
            PG8_LDB(B0, 1, 0); PG8_SCHED; PG8_LDA(At, 1, 0); PG8_STAGE(PG8_SA(0, 1), a2 + hstep, voffA);
            PG8_WAIT_L(8); PG8_BAR; PG8_WAIT_L(0); PG8_MMA(0, 0, At, B0); PG8_BAR; PG8_SCHED;
            PG8_LDB(B1, 1, 1); PG8_STAGE(PG8_SB(1, 0), b3, voffB);
            PG8_BAR; PG8_WAIT_L(0); PG8_MMA(0, 1, At, B1); PG8_BAR;
            PG8_LDA(At, 1, 1); PG8_STAGE(PG8_SA(1, 0), a3, voffA);
            PG8_BAR; PG8_WAIT_L(0); PG8_MMA(1, 0, At, B0); PG8_BAR; PG8_SCHED;
            PG8_STAGE(PG8_SB(1, 1), b3 + hstep, voffB);
            PG8_WAIT_V(6); PG8_BAR; PG8_MMA(1, 1, At, B1); PG8_BAR;
            }
        }
        if constexpr (ALIGN_EPI) { if (wr == 0) PG8_BAR; }
        if constexpr (!Epi::AFTER_DRAIN) { E(acc, cur, wr, wc, fr, fq, ui & 1); S.done(cur); }
        if (!has_next) break;
#pragma unroll
        for (int a = 0; a < 2; ++a)
#pragma unroll
            for (int b = 0; b < 2; ++b)
#pragma unroll
                for (int m = 0; m < 4; ++m)
#pragma unroll
                    for (int n = 0; n < 2; ++n) acc[a][b][m][n] = (f32x4){0.f, 0.f, 0.f, 0.f};
        cur = nxt; cA = nA; cB = nB; ++ui;
        E.pre(lds, cur, ui & 1, tid, wid);
        if constexpr (ALIGN_EPI) { if (wr == 1) PG8_BAR; }
    }
    PG8_WAIT_V(0);
    if constexpr (!ALIGN_EPI) { if (wr == 0) PG8_BAR; }
    PG8_BAR;
    if constexpr (Epi::AFTER_DRAIN) { E.fused(acc, cur, wr, wc, fr, fq, lds, wid, lane); S.done(cur); }
#undef PG8_SA
#undef PG8_SB
#undef PG8_STAGE
#undef PG8_LDA
#undef PG8_LDB
#undef PG8_MMA
#undef PG8_WAIT_V
#undef PG8_WAIT_L
#undef PG8_BAR
#undef PG8_SCHED
}
}

namespace att {
typedef unsigned short bf16;
typedef short bf16x8 __attribute__((ext_vector_type(8)));
typedef short s16x4 __attribute__((ext_vector_type(4)));
typedef float f32x16 __attribute__((ext_vector_type(16)));
typedef float f32x4 __attribute__((ext_vector_type(4)));
typedef unsigned u32x4 __attribute__((ext_vector_type(4)));
constexpr int NW = 8, QBLK = 32, KVBLK = 64, QB = NW * QBLK, D = 128, PITCH = 6144, OPITCH = 2048, NQB = 8192 / QB;
constexpr int SHM_V = KVBLK * D * 2, SHM_K = KVBLK * D * 2;
constexpr int OFF_WS = 2 * SHM_V + 2 * SHM_K, OFF_BIAS = OFF_WS + NW * 64 * 4, OFF_FLAG = OFF_BIAS + 512, OFF_CB = 69632  , OFF_SCH = OFF_CB + 8192 * 4  , LIST_CAP = 512, LDS_BYTES = OFF_SCH + (32 + LIST_CAP + 4 + 64) * 4;
static_assert(OFF_FLAG + 128 <= OFF_CB, "attention LDS map");
constexpr int BLK_OVH = 4;
constexpr float THR2 = 8.f;
#define KSWZ(row, colB) ((row) * 256 + ((colB) ^ (((row) & 7) << 4)))
#define SBAR() __builtin_amdgcn_sched_barrier(0)
__device__ __forceinline__ int v_st(int k, int c) { const int kk = (k & ~0xC) | ((k & 4) << 1) | ((k & 8) >> 1); return ((kk >> 3) * 4 + (c >> 5)) * 512 + ((kk & 7) * 32 + (c & 31)) * 2; }
__device__ __forceinline__ int v_rd_base(int lane) { return ((lane & 3) << 3) | (((lane >> 2) & 3) << 6) | (((lane >> 4) & 1) << 5) | (((lane >> 5) & 1) << 8); }
constexpr int v_rd_off(int d0, int ks, int half) { return d0 * 512 + ks * 4096 + half * 2048; }
__device__ __forceinline__ int crow(int r, int hi) { return (r & 3) + 8 * (r >> 2) + 4 * hi; }
__device__ __forceinline__ unsigned cvtpk(float lo, float hi) { unsigned r; asm volatile("v_cvt_pk_bf16_f32 %0, %1, %2" : "=v"(r) : "v"(lo), "v"(hi)); return r; }
template <int MLIM> __device__ __forceinline__ void mask_tile(f32x16& p0, f32x16& p1, int dq) {
    const float NEG = -__builtin_inff();
#pragma unroll
    for (int r = 0; r < 16; ++r) { const int c = (r & 3) + 8 * (r >> 2);
        if (dq - c < MLIM) p0[r] = NEG;
        if (dq - c - 32 < MLIM) p1[r] = NEG; }
}
__device__ __forceinline__ void partialSM(f32x16& p0, f32x16& p1, float& m_reg, float& alpha) {
    float pmax = p0[0];
#pragma unroll
    for (int r = 1; r < 16; ++r) pmax = fmaxf(pmax, p0[r]);
#pragma unroll
    for (int r = 0; r < 16; ++r) pmax = fmaxf(pmax, p1[r]);
    { auto rr = __builtin_amdgcn_permlane32_swap(__float_as_uint(pmax), __float_as_uint(pmax), false, false);
      pmax = fmaxf(__uint_as_float(rr[0]), __uint_as_float(rr[1])); }
    float mn;
    if (__builtin_expect(__all((pmax - m_reg) <= THR2), 1)) { mn = m_reg; alpha = 1.f; }
    else { mn = fmaxf(m_reg, pmax); alpha = __builtin_amdgcn_exp2f(m_reg - mn); m_reg = mn; }
#pragma unroll
    for (int r = 0; r < 16; ++r) { p0[r] -= mn; p1[r] -= mn; }
#pragma unroll
    for (int r = 0; r < 16; ++r) p0[r] = __builtin_amdgcn_exp2f(p0[r]);
}
#define ATT_PK4(P, B_, OUT) do { unsigned a0 = cvtpk(P[B_+0], P[B_+1]), a1 = cvtpk(P[B_+2], P[B_+3]);                          \
        unsigned b0 = cvtpk(P[B_+4], P[B_+5]), b1 = cvtpk(P[B_+6], P[B_+7]);                                             \
        auto r0 = __builtin_amdgcn_permlane32_swap(a0, b0, false, false); auto r1 = __builtin_amdgcn_permlane32_swap(a1, b1, false, false); \
        u32x4 w = {r0[0], r1[0], r0[1], r1[1]}; OUT = *reinterpret_cast<bf16x8*>(&w); } while (0)
__device__ __forceinline__ void finishSM(f32x16& p0, f32x16& p1, float alpha, float& l_reg, bf16x8& pa0, bf16x8& pa1, bf16x8& pa2, bf16x8& pa3) {
#pragma unroll
    for (int r = 0; r < 16; ++r) p1[r] = __builtin_amdgcn_exp2f(p1[r]);
    float ps = 0;
#pragma unroll
    for (int r = 0; r < 16; ++r) ps += p0[r];
#pragma unroll
    for (int r = 0; r < 16; ++r) ps += p1[r];
    { auto rr = __builtin_amdgcn_permlane32_swap(__float_as_uint(ps), __float_as_uint(ps), false, false);
      ps = __uint_as_float(rr[0]) + __uint_as_float(rr[1]); }
    l_reg = l_reg * alpha + ps;
    ATT_PK4(p0, 0, pa0); ATT_PK4(p0, 8, pa1); ATT_PK4(p1, 0, pa2); ATT_PK4(p1, 8, pa3);
}
typedef float f32x2 __attribute__((ext_vector_type(2)));
__device__ __forceinline__ void pp_softmax(f32x16& p0, f32x16& p1, float& m_reg, float& l_reg, float& alpha, const bool nomax, bf16x8& pa0, bf16x8& pa1, bf16x8& pa2, bf16x8& pa3) {
    float mn = m_reg; alpha = 1.f;
    if (!nomax) {
        float pmax = p0[0];
#pragma unroll
        for (int r = 1; r < 16; ++r) pmax = fmaxf(pmax, p0[r]);
#pragma unroll
        for (int r = 0; r < 16; ++r) pmax = fmaxf(pmax, p1[r]);
        { auto rr = __builtin_amdgcn_permlane32_swap(__float_as_uint(pmax), __float_as_uint(pmax), false, false);
          pmax = fmaxf(__uint_as_float(rr[0]), __uint_as_float(rr[1])); }
        if (!__builtin_expect(__all((pmax - m_reg) <= THR2), 1)) { mn = fmaxf(m_reg, pmax); alpha = __builtin_amdgcn_exp2f(m_reg - mn); m_reg = mn; }
    }
    const f32x2 mm = {mn, mn}; f32x2 s2 = {0.f, 0.f};
#pragma unroll
    for (int r = 0; r < 8; ++r) { f32x2 a = {p0[2 * r], p0[2 * r + 1]}; a -= mm; a[0] = __builtin_amdgcn_exp2f(a[0]); a[1] = __builtin_amdgcn_exp2f(a[1]); s2 += a; p0[2 * r] = a[0]; p0[2 * r + 1] = a[1]; }
#pragma unroll
    for (int r = 0; r < 8; ++r) { f32x2 a = {p1[2 * r], p1[2 * r + 1]}; a -= mm; a[0] = __builtin_amdgcn_exp2f(a[0]); a[1] = __builtin_amdgcn_exp2f(a[1]); s2 += a; p1[2 * r] = a[0]; p1[2 * r + 1] = a[1]; }
    float ps = s2[0] + s2[1];
    { auto rr = __builtin_amdgcn_permlane32_swap(__float_as_uint(ps), __float_as_uint(ps), false, false);
      ps = __uint_as_float(rr[0]) + __uint_as_float(rr[1]); }
    l_reg = l_reg * alpha + ps;
    ATT_PK4(p0, 0, pa0); ATT_PK4(p0, 8, pa1); ATT_PK4(p1, 0, pa2); ATT_PK4(p1, 8, pa3);
}
__device__ __forceinline__ void sb_partial(f32x16& p0, f32x16& p1, float& R, int dq, bool needmask, int hi) {
    float G[8];
#pragma unroll
    for (int j = 0; j < 8; ++j) { float lom[4];
#pragma unroll
        for (int e = 0; e < 4; ++e) { const int r = 4 * (j & 3) + e; const float z = (j < 4) ? p0[r] : p1[r];
            const float ex = __builtin_amdgcn_exp2f(-__builtin_fabsf(z)); const float lg = __builtin_amdgcn_logf(1.0f + ex);
            float ls = fminf(z, 0.f) - lg; float lo = ls - z;
            if (needmask) { const int c = e + 8 * (j & 3) + ((j < 4) ? 0 : 32); if (dq - c < 1) { lo = 0.f; ls = -__builtin_inff(); } }
            lom[e] = lo; if (j < 4) p0[r] = ls; else p1[r] = ls; }
        const float w2 = lom[3], w1 = w2 + lom[2], w0 = w1 + lom[1]; G[j] = w0 + lom[0];
        const int rb = 4 * (j & 3);
        if (j < 4) { p0[rb + 2] += w2; p0[rb + 1] += w1; p0[rb + 0] += w0; } else { p1[rb + 2] += w2; p1[rb + 1] += w1; p1[rb + 0] += w0; }
    }
    float S = R;
#pragma unroll
    for (int j = 7; j >= 0; --j) { auto rr = __builtin_amdgcn_permlane32_swap(__float_as_uint(G[j]), __float_as_uint(G[j]), false, false);
        const float Pn = hi ? __uint_as_float(rr[0]) : __uint_as_float(rr[1]);
        const float above = S + (hi ? 0.f : Pn);
        const int rb = 4 * (j & 3);
#pragma unroll
        for (int e = 0; e < 4; ++e) { if (j < 4) p0[rb + e] += above; else p1[rb + e] += above; }
        S += (hi ? (Pn + G[j]) : (G[j] + Pn)); }
    R = S;
}
__device__ __forceinline__ void sb_finish(f32x16& p0, f32x16& p1, bf16x8& pa0, bf16x8& pa1, bf16x8& pa2, bf16x8& pa3) {
#pragma unroll
    for (int r = 0; r < 16; ++r) { p0[r] = __builtin_amdgcn_exp2f(p0[r]); p1[r] = __builtin_amdgcn_exp2f(p1[r]); }
    ATT_PK4(p0, 0, pa0); ATT_PK4(p0, 8, pa1); ATT_PK4(p1, 0, pa2); ATT_PK4(p1, 8, pa3);
}
template <int KB, int KIND>
__device__ __forceinline__ void qkt(f32x16& p0, f32x16& p1, const char* K_lds, const char* B_lds, int r32, int hi, const bf16x8* qr) {
    if (KIND == 0) { const char* bb = B_lds + KB * 256 + hi * 16;
#pragma unroll
        for (int i = 0; i < 4; ++i) { const f32x4 b0 = *reinterpret_cast<const f32x4*>(bb + i * 32), b1 = *reinterpret_cast<const f32x4*>(bb + 128 + i * 32);
#pragma unroll
            for (int e = 0; e < 4; ++e) { p0[4 * i + e] = b0[e]; p1[4 * i + e] = b1[e]; } } }
    else { p0 = f32x16{}; p1 = f32x16{}; }
    const char* kb[4];
#pragma unroll
    for (int dd = 0; dd < 4; ++dd) kb[dd] = K_lds + KB * SHM_K + KSWZ(r32, (dd * 16 + hi * 8) * 2);
#pragma unroll
    for (int d0 = 0; d0 < 8; ++d0) { const char* a = kb[d0 & 3] + (d0 >> 2) * 128;
        bf16x8 b0 = *reinterpret_cast<const bf16x8*>(a);
        bf16x8 b1 = *reinterpret_cast<const bf16x8*>(a + 32 * 256);
        p0 = __builtin_amdgcn_mfma_f32_32x32x16_bf16(b0, qr[d0], p0, 0, 0, 0);
        p1 = __builtin_amdgcn_mfma_f32_32x32x16_bf16(b1, qr[d0], p1, 0, 0, 0);
        if (d0 & 1) SBAR(); }
}
template <int VB>
__device__ __forceinline__ void pv_tile(f32x16* o, int vb0, bf16x8 pa0, bf16x8 pa1, bf16x8 pa2, bf16x8 pa3) {
#define TRRD(dst, off) asm volatile("ds_read_b64_tr_b16 %0, %1 offset:%2" : "=&v"(dst) : "v"(vb0), "i"(off) : "memory")
#define PV_D0(d0) do { s16x4 l0, l1, l2, l3, h0, h1, h2, h3; constexpr int b_ = VB * SHM_V + v_rd_off(d0, 0, 0); \
        TRRD(l0, b_); TRRD(h0, b_ + 2048); TRRD(l1, b_ + 4096); TRRD(h1, b_ + 6144); TRRD(l2, b_ + 8192); TRRD(h2, b_ + 10240); TRRD(l3, b_ + 12288); TRRD(h3, b_ + 14336); \
        asm volatile("s_waitcnt lgkmcnt(0)" ::: "memory"); SBAR();   \
        o[d0] = __builtin_amdgcn_mfma_f32_32x32x16_bf16(pa0, (bf16x8){l0[0], l0[1], l0[2], l0[3], h0[0], h0[1], h0[2], h0[3]}, o[d0], 0, 0, 0);   \
        o[d0] = __builtin_amdgcn_mfma_f32_32x32x16_bf16(pa1, (bf16x8){l1[0], l1[1], l1[2], l1[3], h1[0], h1[1], h1[2], h1[3]}, o[d0], 0, 0, 0);   \
        o[d0] = __builtin_amdgcn_mfma_f32_32x32x16_bf16(pa2, (bf16x8){l2[0], l2[1], l2[2], l2[3], h2[0], h2[1], h2[2], h2[3]}, o[d0], 0, 0, 0);   \
        o[d0] = __builtin_amdgcn_mfma_f32_32x32x16_bf16(pa3, (bf16x8){l3[0], l3[1], l3[2], l3[3], h3[0], h3[1], h3[2], h3[3]}, o[d0], 0, 0, 0); } while (0)
    PV_D0(0); PV_D0(1); PV_D0(2); PV_D0(3);
#undef PV_D0
#undef TRRD
}
struct BlockRef { const bf16* Q; const bf16* K; const bf16* V; bf16* O; int P0; };
struct Seam { bf16x8 qr[8]; bf16x8 st_v0, st_v1, st_k0, st_k1; f32x4 st_b; };
template <int KIND> __device__ __forceinline__ int first_kb(int P0) { return P0 + QB - KVBLK; }
#define AROW(p, k0, rr) ((p) + (size_t)((k0) + (rr)) * PITCH + sc)
#define VMW() asm volatile("s_waitcnt vmcnt(0)" ::: "memory")
#define VMWN(n) asm volatile("s_waitcnt vmcnt(%0)" :: "i"(n) : "memory")
#define LD8(p) (*reinterpret_cast<const bf16x8*>(p))
#define SLOAD_B(R_, k0) do { if (KIND == 0 && tid < 16) { const f32x4 t_ = *(const f32x4*)(CB_lds + (k0) + 4 * tid); const float cr_ = CB_lds[(R_).P0]; S.st_b = t_ - cr_; } } while (0)
#define SLOAD_H(R_, k0) do { S.st_v0 = LD8(AROW((R_).V, k0, sr)); S.st_v1 = LD8(AROW((R_).V, k0, 32 + sr)); S.st_k0 = LD8(AROW((R_).K, k0, sr)); S.st_k1 = LD8(AROW((R_).K, k0, 32 + sr)); SLOAD_B(R_, k0); } while (0)
#define SWRITE_HK(bf) do { *(bf16x8*)(K_lds + (bf) * SHM_K + kws) = S.st_k0; *(bf16x8*)(K_lds + (bf) * SHM_K + kws + 32 * 256) = S.st_k1; \
                           if (KIND == 0 && tid < 16) *(f32x4*)(B_lds + (bf) * 256 + tid * 16) = S.st_b; } while (0)
#define SWRITE_HV(bf) do { *(bf16x8*)(V_lds + (bf) * SHM_V + vst0) = S.st_v0; *(bf16x8*)(V_lds + (bf) * SHM_V + vst1) = S.st_v1; } while (0)
#define SWRITE_H(bf) do { SWRITE_HV(bf); SWRITE_HK(bf); } while (0)
template <int KIND>
__device__ __forceinline__ void attn_prime(const BlockRef& cur, char* lds, Seam& S, const int tid) {
    const int wid = __builtin_amdgcn_readfirstlane(tid >> 6), lane = tid & 63, r32 = lane & 31, hi = lane >> 5;
    const int sr = tid >> 4, sc = (tid & 15) * 8, kws = KSWZ(sr, sc * 2); char* K_lds = lds + 2 * SHM_V; char* B_lds = lds + OFF_BIAS; const float* CB_lds = (const float*)(lds + OFF_CB);
    const int kb0 = first_kb<KIND>(cur.P0);
#pragma unroll
    for (int d0 = 0; d0 < 8; ++d0) S.qr[d0] = LD8(cur.Q + (size_t)(wid * QBLK + r32) * PITCH + d0 * 16 + hi * 8);
    SLOAD_H(cur, kb0); VMW(); SWRITE_HK(0);
    __syncthreads();
}
template <int KIND>
__device__ __forceinline__ void attn_block(const BlockRef& cur, const BlockRef& nxt, char* lds, Seam& S, const int tid, const int ntiles) {
    constexpr int MLIM = (KIND == 2) ? 1 : 0;
    const int wid = __builtin_amdgcn_readfirstlane(tid >> 6), lane = tid & 63, r32 = lane & 31, hi = lane >> 5;
    const int NT0 = cur.P0 / KVBLK + QB / KVBLK; int NT = ntiles;
    const int kbn = first_kb<KIND>(nxt.P0);
    const int qlo = cur.P0 + wid * QBLK, qm = qlo + r32 - 4 * hi;
    char* V_lds = lds; char* K_lds = lds + 2 * SHM_V; char* B_lds = lds + OFF_BIAS; const float* CB_lds = (const float*)(lds + OFF_CB);
    float* ws = (float*)(lds + OFF_WS) + wid * 64; float* li_l = ws, * al_l = ws + 32;
    float m_reg = -1e30f, l_reg = 0.f, R = 0.f; f32x16 o[4] = {};
    const int sr = tid >> 4, sc = (tid & 15) * 8, vst0 = v_st(sr, sc), vst1 = v_st(32 + sr, sc), kws = KSWZ(sr, sc * 2);
    const int vb0 = (int)(uintptr_t)V_lds + v_rd_base(lane);
#define RESC(a) do { if (KIND == 0) { if (__any((a) < 1.f)) { if (hi == 0) al_l[r32] = (a); asm volatile("s_waitcnt lgkmcnt(0)" ::: "memory");              \
                     for (int d_ = 0; d_ < 4; ++d_) for (int r = 0; r < 16; ++r) o[d_][r] *= al_l[crow(r, hi)]; } } } while (0)
#define KBASE(t) ((NT0 - 1 - (t)) * KVBLK)
#define NEEDM(kb_) ((kb_) + KVBLK - 1 + MLIM > qlo)
#define SM1(PX0, PX1, alX, t) do { const int kb_ = KBASE(t); if (KIND == 0) { if (NEEDM(kb_)) mask_tile<0>(PX0, PX1, qm - kb_); partialSM(PX0, PX1, m_reg, alX); } \
                                   else { sb_partial(PX0, PX1, R, qm - kb_, NEEDM(kb_), hi); sb_finish(PX0, PX1, pa0, pa1, pa2, pa3); } } while (0)
#define SM2(PY0, PY1, alY) do { if (KIND == 0) finishSM(PY0, PY1, alY, l_reg, pa0, pa1, pa2, pa3); } while (0)
    constexpr int NQL = 8;
#define SEAM_K0() do { VMWN(NQL); SWRITE_HK(0); SBAR(); } while (0)
    f32x16 pA0, pA1, pB0, pB1; float alA = 1.f, alB = 1.f; bf16x8 pa0, pa1, pa2, pa3;
    SWRITE_HV(0); SBAR();
    if (NT > 1) SLOAD_H(cur, KBASE(1));
    SBAR(); qkt<0, KIND>(pA0, pA1, K_lds, B_lds, r32, hi, S.qr);
    SM1(pA0, pA1, alA, 0);
    if (NT > 1) { VMW(); SWRITE_H(1); }
    __syncthreads();
#define HALF_STEP(PX0, PX1, alX, PY0, PY1, alY, t, KB, VB, SB, CHK) do {                                                      \
        SBAR(); qkt<KB, KIND>(PX0, PX1, K_lds, B_lds, r32, hi, S.qr);                                             \
        SM2(PY0, PY1, alY); SBAR();                                                           \
        if ((t) + 1 < NT) { SLOAD_H(cur, KBASE((t) + 1)); SBAR(); }                                               \
        pv_tile<VB>(o, vb0, pa0, pa1, pa2, pa3); SM1(PX0, PX1, alX, (t));                                        \
        if (KIND == 2 && (CHK)) { const bool wd_ = __all(R < -160.f); if (lane == 0) flg[wid] = wd_ ? 1 : 0; }            \
        __syncthreads();                                                                                                      \
        if (KIND == 2 && (CHK)) { const int4 f0_ = *(const int4*)flg, f1_ = *(const int4*)(flg + 4);                          \
            done_all = (f0_.x & f0_.y & f0_.z & f0_.w & f1_.x & f1_.y & f1_.z & f1_.w) != 0; }                                \
        if ((t) + 1 < NT) { VMW(); SWRITE_H(SB); }                                                                          \
        RESC(alX); __syncthreads(); } while (0)
    int* flg = (int*)(lds + OFF_FLAG); bool done_all = false;
    for (int t = 1; t + 1 < NT; t += 2) {
        HALF_STEP(pB0, pB1, alB, pA0, pA1, alA, t, 1, 0, 0, false);
        HALF_STEP(pA0, pA1, alA, pB0, pB1, alB, t + 1, 0, 1, 1, true);
        if (KIND == 2 && done_all) NT = t + 3;
    }
    constexpr bool even = true;
    if (even) { SBAR(); qkt<1, KIND>(pB0, pB1, K_lds, B_lds, r32, hi, S.qr); SBAR(); }
    SLOAD_H(nxt, kbn); SBAR();
#pragma unroll
    for (int d0 = 0; d0 < 8; ++d0) S.qr[d0] = LD8(nxt.Q + (size_t)(wid * QBLK + r32) * PITCH + d0 * 16 + hi * 8);
    SBAR();
    SM2(pA0, pA1, alA); SBAR();
    pv_tile<0>(o, vb0, pa0, pa1, pa2, pa3);
    if (even) { SM1(pB0, pB1, alB, NT - 1); __syncthreads(); RESC(alB);
        SM2(pB0, pB1, alB); SBAR(); pv_tile<1>(o, vb0, pa0, pa1, pa2, pa3); }
    SBAR(); SEAM_K0();
    float rli[16];
    if (KIND == 0) { if (hi == 0) li_l[r32] = l_reg; asm volatile("s_waitcnt lgkmcnt(0)" ::: "memory");
#pragma unroll
        for (int r = 0; r < 16; ++r) rli[r] = __builtin_amdgcn_rcpf(li_l[crow(r, hi)]); }
    else {
#pragma unroll
        for (int r = 0; r < 16; ++r) rli[r] = 1.f; }
    bf16* Ow = cur.O + (size_t)(wid * QBLK) * OPITCH;
#pragma unroll
    for (int r = 0; r < 16; ++r) { const int orow = crow(r, hi);
#pragma unroll
        for (int d0 = 0; d0 < 4; ++d0) { const float v = o[d0][r] * rli[r]; const float vn = __shfl_xor(v, 1);
            if ((r32 & 1) == 0) *(unsigned*)(Ow + (size_t)orow * OPITCH + d0 * 32 + r32) = cvtpk(v, vn); } }
    __syncthreads();
#undef RESC
#undef KBASE
#undef NEEDM
#undef SM1
#undef SM2
#undef SEAM_K0
#undef HALF_STEP
}
template <int KIND>
__device__ __forceinline__ void attn_block_pp(const BlockRef& cur, char* lds, const int tid, const int ntiles, const float bq) {
    const int wid = __builtin_amdgcn_readfirstlane(tid >> 6), lane = tid & 63, r32 = lane & 31, hi = lane >> 5, g = wid >> 2;
    const int NT0 = cur.P0 / KVBLK + QB / KVBLK; const int NT = ntiles;
    const int qlo = cur.P0 + wid * QBLK, qm = qlo + r32 - 4 * hi;
    char* V_lds = lds; char* K_lds = lds + 2 * SHM_V; char* B_lds = lds + OFF_BIAS; const float* CB_lds = (const float*)(lds + OFF_CB);
    float* ws = (float*)(lds + OFF_WS) + wid * 64; float* li_l = ws, * al_l = ws + 32;
    float m_reg = -1e30f, l_reg = 0.f; f32x16 o[4] = {};
    const int sr = tid >> 4, sc = (tid & 15) * 8, vst0 = v_st(sr, sc), vst1 = v_st(32 + sr, sc), kws = KSWZ(sr, sc * 2);
    const int vb0 = (int)(uintptr_t)V_lds + v_rd_base(lane);
    bf16x8 qr[8], sk0[2], sk1[2], sv0[2], sv1[2];
#define KBASE(t) ((NT0 - 1 - (t)) * KVBLK)
#define CLAMPT(t) ((t) < NT ? (t) : NT - 1)
#define LOADK(S_, t) do { const int k0_ = KBASE(CLAMPT(t)); sk0[S_] = LD8(AROW(cur.K, k0_, sr)); sk1[S_] = LD8(AROW(cur.K, k0_, 32 + sr)); } while (0)
#define LOADV(S_, t) do { const int k0_ = KBASE(CLAMPT(t)); sv0[S_] = LD8(AROW(cur.V, k0_, sr)); sv1[S_] = LD8(AROW(cur.V, k0_, 32 + sr)); } while (0)
#define WRITEK(S_, bf, t) do { *(bf16x8*)(K_lds + (bf) * SHM_K + kws) = sk0[S_]; *(bf16x8*)(K_lds + (bf) * SHM_K + kws + 32 * 256) = sk1[S_]; \
        if (tid < 16) { const f32x4 t_ = *(const f32x4*)(CB_lds + KBASE(t) + 4 * tid); const float cr_ = CB_lds[cur.P0]; *(f32x4*)(B_lds + (bf) * 256 + tid * 16) = t_ - cr_; } } while (0)
#define WRITEV(S_, bf) do { *(bf16x8*)(V_lds + (bf) * SHM_V + vst0) = sv0[S_]; *(bf16x8*)(V_lds + (bf) * SHM_V + vst1) = sv1[S_]; } while (0)
#define STAGE(S_, t) do { VMWN(4); if ((t) + 1 + g < NT) WRITEK(S_, ((t) + 1 + g) & 1, (t) + 1 + g); if ((t) + g < NT) WRITEV(S_, ((t) + g) & 1); \
        LOADK(S_, (t) + 3 + g); LOADV(S_, (t) + 2 + g); } while (0)
#define RESC(a) do { if (__any((a) < 1.f)) { if (hi == 0) al_l[r32] = (a); asm volatile("s_waitcnt lgkmcnt(0)" ::: "memory");              \
                     for (int d_ = 0; d_ < 4; ++d_) for (int r = 0; r < 16; ++r) o[d_][r] *= al_l[crow(r, hi)]; } } while (0)
    { const bf16x8 k00 = LD8(AROW(cur.K, KBASE(0), sr)), k01 = LD8(AROW(cur.K, KBASE(0), 32 + sr));
#pragma unroll
      for (int d0 = 0; d0 < 8; ++d0) qr[d0] = LD8(cur.Q + (size_t)(wid * QBLK + r32) * PITCH + d0 * 16 + hi * 8);
      if (g == 0) { LOADK(0, 1); LOADV(0, 0); LOADK(1, 2); LOADV(1, 1); }
      else        { LOADK(1, 1); LOADV(1, 0); LOADK(0, 2); LOADV(0, 1); }
      VMWN(16);
      *(bf16x8*)(K_lds + kws) = k00; *(bf16x8*)(K_lds + kws + 32 * 256) = k01;
      if (tid < 16) { const f32x4 t_ = *(const f32x4*)(CB_lds + KBASE(0) + 4 * tid); const float cr_ = CB_lds[cur.P0]; *(f32x4*)(B_lds + tid * 16) = t_ - cr_; } }
    __syncthreads();
    if (g == 1) { STAGE(1, -1); __syncthreads(); }
    f32x16 p0, p1; bf16x8 pa0, pa1, pa2, pa3; float al = 1.f;
#define MSEG(t, KB, VP) do { __builtin_amdgcn_s_setprio(1); if ((t) > 0) pv_tile<VP>(o, vb0, pa0, pa1, pa2, pa3); SBAR(); qkt<KB, KIND>(p0, p1, K_lds, B_lds, r32, hi, qr); __builtin_amdgcn_s_setprio(0); } while (0)
#define VSEG(S_, t) do { STAGE(S_, t); SBAR(); const int kb_ = KBASE(t); if (kb_ + KVBLK - 1 > qlo) { mask_tile<0>(p0, p1, qm - kb_); asm volatile("" : "+v"(p0), "+v"(p1)); }     const bool nomax_ = __all(bq + (CB_lds[kb_ + KVBLK - 1] - CB_lds[cur.P0]) <= m_reg + THR2); pp_softmax(p0, p1, m_reg, l_reg, al, nomax_, pa0, pa1, pa2, pa3); RESC(al); } while (0)
    for (int t = 0; t < NT; t += 2) {
        MSEG(t, 0, 1); __syncthreads();
        VSEG(0, t); __syncthreads();
        MSEG(t + 1, 1, 0); __syncthreads();
        VSEG(1, t + 1); __syncthreads();
    }
    pv_tile<1>(o, vb0, pa0, pa1, pa2, pa3);
    __syncthreads();
    if (g == 0) __syncthreads();
    float rli[16];
    if (hi == 0) li_l[r32] = l_reg; asm volatile("s_waitcnt lgkmcnt(0)" ::: "memory");
#pragma unroll
    for (int r = 0; r < 16; ++r) rli[r] = __builtin_amdgcn_rcpf(li_l[crow(r, hi)]);
    bf16* Ow = cur.O + (size_t)(wid * QBLK) * OPITCH;
#pragma unroll
    for (int r = 0; r < 16; ++r) { const int orow = crow(r, hi);
#pragma unroll
        for (int d0 = 0; d0 < 4; ++d0) { const float v = o[d0][r] * rli[r]; const float vn = __shfl_xor(v, 1);
            if ((r32 & 1) == 0) *(unsigned*)(Ow + (size_t)orow * OPITCH + d0 * 32 + r32) = cvtpk(v, vn); } }
    __syncthreads();
#undef KBASE
#undef CLAMPT
#undef LOADK
#undef LOADV
#undef WRITEK
#undef WRITEV
#undef STAGE
#undef RESC
#undef MSEG
#undef VSEG
}
#undef AROW
#undef VMW
#undef VMWN
#undef LD8
#undef SLOAD_B
#undef SLOAD_H
#undef SWRITE_HK
#undef SWRITE_HV
#undef SWRITE_H
template <int KIND>
__device__ __forceinline__ void attn_phase(char* lds, const bf16* QKV, bf16* OB, const float* LOGF, const float* qg, const float* kg, const int wave_id, const int probe = 0) {
    const int total = 16 * (NQB / 2), stride = gridDim.x;
    const int L0 = blockIdx.x; if (L0 >= total) return;
    int tid = MK_TID(wave_id); asm volatile("" : "+v"(tid));
    int* sch_nt = (int*)(lds + OFF_SCH); int* list = sch_nt + 32; int* pcnt = list + LIST_CAP;
    int cb_head = -1; float bq_head = 3.0e38f;
#define LOAD_CB(H_) do { if (KIND == 0) { const int h_ = (H_); if (h_ != cb_head) { cb_head = h_; \
        float* cbw = (float*)(lds + OFF_CB); float* wt_ = (float*)(lds + OFF_WS); const int lane_ = tid & 63, wv_ = tid >> 6, t0_ = tid * 16; \
        f32x4 lf_[4]; _Pragma("unroll") for (int q_ = 0; q_ < 4; ++q_) lf_[q_] = *(const f32x4*)(LOGF + (size_t)h_ * 8192 + t0_ + 4 * q_); \
        float v_[16]; float run_ = 0.f; _Pragma("unroll") for (int i_ = 0; i_ < 16; ++i_) { run_ += lf_[i_ >> 2][i_ & 3]; v_[i_] = run_; } \
        float inc_ = run_; _Pragma("unroll") for (int o_ = 1; o_ < 64; o_ <<= 1) { const float tv_ = __shfl_up(inc_, o_); if (lane_ >= o_) inc_ += tv_; } \
        __syncthreads(); if (lane_ == 63) wt_[wv_] = inc_; __syncthreads(); \
        float wb_ = 0.f; for (int w_ = 0; w_ < wv_; ++w_) wb_ += wt_[w_]; const float ex_ = wb_ + inc_ - run_; \
        _Pragma("unroll") for (int i_ = 0; i_ < 16; ++i_) cbw[t0_ + i_] = -(ex_ + v_[i_]) * 1.4426950408889634f; \
        __syncthreads(); } } } while (0)
#define PACK_E(h_, qb_, nt_) (((h_) << 16) | ((qb_) << 8) | (nt_))
    if (KIND == 0 && stride == 256) {
        const int lane = tid & 63;
        float mq = fmaxf(__builtin_fabsf(qg[lane]), __builtin_fabsf(qg[lane + 64])), mk = fmaxf(__builtin_fabsf(kg[lane]), __builtin_fabsf(kg[lane + 64]));
#pragma unroll
        for (int o = 1; o < 64; o <<= 1) { mq = fmaxf(mq, __shfl_xor(mq, o)); mk = fmaxf(mk, __shfl_xor(mk, o)); }
        const float Bq = 128.0f * (0.08838834764831845f * 1.4426950408889634f) * mq * mk * 1.01f;
        const float Tcut = -(136.0f + THR2 + 2.0f * Bq); bq_head = Bq;
        float* sch_f = (float*)(pcnt + 4); int* sch_nh = (int*)(sch_f + 32); int* sch_st = sch_nh + 16;
        { const int hh = tid >> 5, jj = tid & 31; float s = 0.f;
#pragma unroll
          for (int i = 0; i < 16; ++i) s += LOGF[(size_t)hh * 8192 + jj * 256 + i * 16 + 7];
#pragma unroll
          for (int o = 1; o < 32; o <<= 1) s += __shfl_xor(s, o);
          if (jj == 0) sch_f[hh] = -s * (1.4426950408889634f / 512.0f); }
        __syncthreads();
        if (tid < 16) { const float rate = fmaxf(sch_f[tid], 1e-6f); float cutf = -Tcut / (rate * 64.0f) + 5.0f; cutf = fminf(fmaxf(cutf, 4.0f), 128.0f); const int cut = (int)cutf;
            const int ovh_ = probe >= 100 ? probe - 100 : BLK_OVH;
            int W = 0; for (int qb = 0; qb < NQB; ++qb) { const int nt0 = 4 * qb + 4; W += (nt0 < cut ? nt0 : cut) + ovh_; }
            sch_f[16 + tid] = (float)W; }
        __syncthreads();
        if (wave_id == 0) {
            const int hh = lane & 15; const float Wf = sch_f[16 + hh];
            float tot = Wf;
#pragma unroll
            for (int o = 1; o < 16; o <<= 1) tot += __shfl_xor(tot, o);
            int nn = (int)(Wf * 256.0f / tot + 0.5f); nn = nn < 1 ? 1 : (nn > NQB ? NQB : nn);
            int s = nn;
#pragma unroll
            for (int o = 1; o < 16; o <<= 1) s += __shfl_xor(s, o);
            while (s != 256) { const bool up = s < 256; int key = (up && nn >= NQB) ? -1 : ((nn << 4) | (15 - hh)), km = key;
#pragma unroll
                for (int o = 1; o < 16; o <<= 1) { const int t_ = __shfl_xor(km, o); km = t_ > km ? t_ : km; }
                if (km < 0) break;
                if (key == km) nn += up ? 1 : -1;
                s += up ? 1 : -1; }
            int st = nn;
#pragma unroll
            for (int o = 1; o < 16; o <<= 1) { const int t_ = __shfl_up(st, o, 16); if (hh >= o) st += t_; }
            if (lane < 16) { sch_nh[hh] = nn; sch_st[hh] = st - nn; } }
        __syncthreads();
        const int v = (L0 & 7) * 32 + (L0 >> 3);
        int h = 0; for (int hh = 1; hh < 16; ++hh) if (v >= sch_st[hh]) h = hh;
        h = __builtin_amdgcn_readfirstlane(h);
        const int w = v - __builtin_amdgcn_readfirstlane(sch_st[h]), nb = __builtin_amdgcn_readfirstlane(sch_nh[h]);
        if (w >= nb) return;
        LOAD_CB(h);
        if (tid < NQB) { const float* cb = (const float*)(lds + OFF_CB); const int nt0 = 4 * tid + 4; const float thr = cb[tid * QB] + Tcut;
            int lo = 0, hi = nt0;
            while (lo < hi) { const int mid = (lo + hi) >> 1; if (cb[64 * mid + 63] < thr) lo = mid + 1; else hi = mid; }
            int nt = nt0 - lo; nt += nt & 1; if (nt < 4) nt = 4; sch_nt[tid] = nt; }
        __syncthreads();
        if (wave_id == 0) {
            int key = lane < NQB ? (((sch_nt[lane] + BLK_OVH) << 6) | lane) : -1;
#pragma unroll
            for (int k = 2; k <= 64; k <<= 1)
#pragma unroll
                for (int j = k >> 1; j > 0; j >>= 1) { const int other = __shfl_xor(key, j); const bool up = ((lane & k) == 0), lower = ((lane & j) == 0);
                    const bool takemax = (lower == up); key = takemax ? (other > key ? other : key) : (other < key ? other : key); }
            int cnt = 0;
            for (int r = 0; r * nb < NQB; ++r) { const int p = r * nb + ((r & 1) ? nb - 1 - w : w);
                if (p < NQB) { const int kp = __builtin_amdgcn_readlane(key, p); if (lane == 0) list[cnt] = PACK_E(h, kp & 63, (kp >> 6) - BLK_OVH); ++cnt; } }
            if (lane == 0) *pcnt = cnt;
        }
        __syncthreads();
    } else {
        if (tid == 0) { int n = 0;
            for (int Lx = L0; Lx < total && n + 2 <= LIST_CAP; Lx += stride) { const int h = (Lx & 7) * 2 + ((Lx >> 3) >> 4), x = (Lx >> 3) & 15;
                list[n++] = PACK_E(h, x, 4 * x + 4); list[n++] = PACK_E(h, NQB - 1 - x, 4 * (NQB - 1 - x) + 4); }
            *pcnt = n; }
        __syncthreads();
    }
    const int n = __builtin_amdgcn_readfirstlane(*pcnt);
    if (n <= 0 || probe == 1) return;
#define ENT_REF(e_, ref) do { const int h_ = (e_) >> 16, qb_ = ((e_) >> 8) & 255; \
        ref.Q = QKV + (size_t)qb_ * QB * PITCH + h_ * D; ref.K = QKV + 2048 + h_ * D; ref.V = QKV + 4096 + h_ * D; ref.O = OB + (size_t)qb_ * QB * OPITCH + h_ * D; \
        ref.P0 = qb_ * QB; } while (0)
    if (KIND == 0) {
        for (int i = 0; i < n; ++i) { const int e0 = __builtin_amdgcn_readfirstlane(list[i]);
            LOAD_CB(e0 >> 16);
            BlockRef cur; ENT_REF(e0, cur);
            int ntl = e0 & 255; if (probe >= 4 && ntl > probe) ntl = probe;
            attn_block_pp<KIND>(cur, lds, tid, ntl, bq_head); }
        return;
    }
    int e = __builtin_amdgcn_readfirstlane(list[0]);
    LOAD_CB(e >> 16);
    BlockRef cur; ENT_REF(e, cur);
    Seam S; S.st_b = f32x4{0.f, 0.f, 0.f, 0.f};
    attn_prime<KIND>(cur, lds, S, tid);
    for (int i = 0;; ++i) {
        const bool last = i + 1 >= n;
        const int en = last ? e : __builtin_amdgcn_readfirstlane(list[i + 1]);
        const bool chain = !last && (KIND != 0 || (en >> 16) == cb_head);
        BlockRef nxt; if (!chain) nxt = cur; else ENT_REF(en, nxt);
        attn_block<KIND>(cur, nxt, lds, S, tid, e & 255);
        if (last) break;
        if (chain) cur = nxt; else { ENT_REF(en, cur); LOAD_CB(en >> 16); attn_prime<KIND>(cur, lds, S, tid); }
        e = en;
    }
#undef ENT_REF
#undef PACK_E
#undef LOAD_CB
}
#undef KSWZ
#undef SBAR
#undef ATT_PK4
}

constexpr int NWAVES = 8;
constexpr int SEQ = 8192, DM = 2048, FF = 5632, NH = 16, HD = 128, DEPTH = 4, NQKV = 3 * DM, FOXN = 3 * DM + NH;
constexpr float LOG2E = 1.4426950408889634f;
constexpr float QSCALE = 0.08838834764831845f * LOG2E;
constexpr float EPS = 1e-6f;
constexpr size_t MiB = 1u << 20;
constexpr size_t WS_CTL = 0, CTL_ZERO_BYTES = 2 * MiB;
constexpr size_t WS_SS = 1 * MiB;
constexpr size_t WS_CNEG = 2 * MiB;
constexpr size_t WS_LOGF = 3 * MiB;
constexpr size_t WS_WFT = 3 * MiB + 512 * 1024;
constexpr size_t WS_XB = 4 * MiB;
constexpr size_t WS_QKV = 36 * MiB;
constexpr size_t WS_OB = 132 * MiB;
constexpr size_t WS_ACT = 164 * MiB;
constexpr size_t WS_W = 256 * MiB, W_LAYER = 164 * MiB;
constexpr size_t W_GU0 = 0, W_D0 = 44 * MiB, W_GU1 = 66 * MiB, W_D1 = 110 * MiB, W_IN = 132 * MiB, W_OUT = 156 * MiB;
constexpr size_t WS_END = WS_W + DEPTH * W_LAYER;
constexpr int CW_BAR = 4096;
constexpr int RING_BYTES = 131072, LDS_BYTES = 147456, LDSCTL_OFF = LDS_BYTES - 512, MISC_OFF = LDSCTL_OFF + 320;
constexpr int N_PHASES = 29;

#define GAS __attribute__((address_space(1)))
#define LAS __attribute__((address_space(3)))
typedef unsigned short bf16;
typedef unsigned v4u __attribute__((ext_vector_type(4)));
typedef unsigned v2u __attribute__((ext_vector_type(2)));
typedef float f32x4 __attribute__((ext_vector_type(4)));
#define LDS_WAIT() asm volatile("s_waitcnt lgkmcnt(0)" ::: "memory")
#define VM_WAIT() asm volatile("s_waitcnt vmcnt(0)" ::: "memory")
__device__ __forceinline__ unsigned f2bf(float f) { unsigned u = __builtin_bit_cast(unsigned, f); return (u + 0x7fffu + ((u >> 16) & 1u)) >> 16; }
__device__ __forceinline__ unsigned pk2(float lo, float hi) { return f2bf(lo) | (f2bf(hi) << 16); }
__device__ __forceinline__ float bf_lo(unsigned w) { return __uint_as_float(w << 16); }
__device__ __forceinline__ float bf_hi(unsigned w) { return __uint_as_float(w & 0xffff0000u); }

#define XB_TMO      128
#define XB_XCNT(j)  (256  + 64 * (j))
#define XB_XSUB(j)  (1280 + 64 * (j))
#define XB_XGEN(j)  (2304 + 64 * (j))
#define XB_TOP      3328
#define XB_TOPGEN   3392
#define XCD_BAR_WORDS 3456
#define XB_SPIN_CAP (1u << 18)

__device__ __forceinline__ unsigned xb_ld(unsigned* p)              { return __hip_atomic_load(p, __ATOMIC_RELAXED, __HIP_MEMORY_SCOPE_AGENT); }
__device__ __forceinline__ unsigned xb_add(unsigned* p, unsigned v) { return __hip_atomic_fetch_add(p, v, __ATOMIC_RELAXED, __HIP_MEMORY_SCOPE_AGENT); }
__device__ __forceinline__ unsigned xb_xcc_id() { return (unsigned)__builtin_amdgcn_s_getreg((3 << 11) | 20) & 0xFu; }
#define XB_SPIN(cond, bar) do { unsigned _sp = 0; while (cond) { __builtin_amdgcn_s_sleep(1); \
    if ((++_sp & 255u) == 0u) { if (xb_ld(&(bar)[XB_TMO])) break; if (_sp > XB_SPIN_CAP) { atomicAdd(&(bar)[XB_TMO], 1u); break; } } } } while (0)

struct XcdBarrier {
    unsigned* bar; unsigned x; unsigned wave;
    volatile LAS unsigned* st;
};

__device__ __forceinline__ XcdBarrier xcd_barrier_post(unsigned* bar, volatile LAS unsigned* st, unsigned wave) {
    XcdBarrier b; b.bar = bar; b.x = xb_xcc_id(); b.st = st; b.wave = wave;
    if (MK_TID(wave) == 0) (void)xb_add(&bar[XB_XCNT(b.x)], 1u);
    return b;
}
__device__ __forceinline__ void xcd_barrier_complete(unsigned* bar, unsigned x, unsigned& nloc, unsigned& nx) {
    const unsigned G = gridDim.x * gridDim.y * gridDim.z;
    unsigned sum, cnt, mine, sp = 0u;
    for (;;) {
        sum = 0u; cnt = 0u; mine = 0u;
#pragma unroll
        for (unsigned j = 0; j < 16; ++j) { const unsigned c = xb_ld(&bar[XB_XCNT(j)]); sum += c; cnt += (c > 0u) ? 1u : 0u; mine = (j == x) ? c : mine; }
        if (sum == G) break;
        __builtin_amdgcn_s_sleep(1);
        if ((++sp & 255u) == 0u) { if (xb_ld(&bar[XB_TMO])) break; if (sp > XB_SPIN_CAP) { atomicAdd(&bar[XB_TMO], 1u); break; } }
    }
    nloc = mine > 0u ? mine : 1u; nx = cnt > 0u ? cnt : 1u;
}

__device__ __forceinline__ void xcd_barrier(const XcdBarrier& b) {
    asm volatile("s_waitcnt vmcnt(0)" ::: "memory");
    __syncthreads();
    if (MK_TID(b.wave) == 0) {
        __attribute__((address_space(1))) unsigned* barg = (__attribute__((address_space(1))) unsigned*)b.bar; asm volatile("" : "+s"(barg)); unsigned* bar = (unsigned*)barg;
        __builtin_amdgcn_s_waitcnt(0);
        unsigned nloc = b.st[0], nx = b.st[1];
        if (nloc == 0u) { xcd_barrier_complete(bar, b.x, nloc, nx); b.st[0] = nloc; b.st[1] = nx; }
        const unsigned old = xb_add(&bar[XB_XSUB(b.x)], 1u);
        const unsigned gen = old / nloc;
        if (old + 1u == (gen + 1u) * nloc) {
            __builtin_amdgcn_fence(__ATOMIC_RELEASE, "agent");
            asm volatile("s_waitcnt vmcnt(0)" ::: "memory");
            const unsigned og = xb_add(&bar[XB_TOP], 1u);
            const unsigned tg = og / nx;
            if (og + 1u == (tg + 1u) * nx) xb_add(&bar[XB_TOPGEN], 1u);
            else XB_SPIN(xb_ld(&bar[XB_TOPGEN]) == tg, bar);
            __builtin_amdgcn_fence(__ATOMIC_ACQUIRE, "agent");
            xb_add(&bar[XB_XGEN(b.x)], 1u);
            asm volatile("s_waitcnt vmcnt(0)" ::: "memory");
        } else {
            XB_SPIN(xb_ld(&bar[XB_XGEN(b.x)]) == gen, bar);
            __builtin_amdgcn_fence(__ATOMIC_ACQUIRE, "agent");
            asm volatile("s_waitcnt vmcnt(0)" ::: "memory");
        }
    }
    __syncthreads();
}

struct Frame {
    LAS unsigned char* lds;
    int wave, gw, ngw;
    float* X;
    unsigned char* ws;
};
typedef const __attribute__((address_space(4))) char* kptr_t;
__device__ __forceinline__ const float* in_ptr(int k) {
    kptr_t kp = (kptr_t)__builtin_amdgcn_kernarg_segment_ptr(); asm volatile("" : "+s"(kp));
    return *(const float* const __attribute__((address_space(4)))*)(kp + 8 * k);
}
__device__ __forceinline__ unsigned char* ws_fresh(unsigned char* w) { GAS unsigned char* g = (GAS unsigned char*)w; asm volatile("" : "+s"(g)); return (unsigned char*)g; }
#define WSP(T, off) ((T*)(ws_fresh(F.ws) + (off)))
__device__ __forceinline__ int fresh_tid_w(int wave) { int t = MK_TID(wave); asm volatile("" : "+v"(t)); return t; }
#define fresh_tid() fresh_tid_w(F.wave)
__device__ __forceinline__ float wave_sum(float v) {
#pragma unroll
    for (int o = 1; o < 64; o <<= 1) v += __shfl_xor(v, o);
    return v;
}
__device__ __forceinline__ float wave_max(float v) {
#pragma unroll
    for (int o = 1; o < 64; o <<= 1) v = fmaxf(v, __shfl_xor(v, o));
    return v;
}
constexpr int TR_SCR_BYTES = 64 * 65 * 4;
constexpr int TR_NGU = (DM / 64) * (FF / 64), TR_NIN = (DM / 64) * (NQKV / 64), TR_NOUT = (DM / 64) * (DM / 64);
constexpr int TR_ITEMS_LAYER = 6 * TR_NGU + TR_NIN + TR_NOUT;
constexpr int TR_ITEMS = DEPTH * TR_ITEMS_LAYER;
constexpr int TR_CHUNK = TR_ITEMS_LAYER / 2;
constexpr int TR_PRO = TR_ITEMS_LAYER - TR_CHUNK - (FF / 64) * (DM / 64);
static_assert(TR_PRO >= 2 * (DM / 64) * (FF / 64) && TR_PRO + TR_CHUNK >= 3 * (DM / 64) * (FF / 64) && TR_PRO + 8 * TR_CHUNK >= TR_ITEMS, "conversion schedule");
struct TrDesc { const float* src; const float* gain; bf16* dst; int ldw, K; };
__device__ __forceinline__ void tr_decode(Frame& F, int g, TrDesc& d) {
    const int l = g / TR_ITEMS_LAYER; int r = g - l * TR_ITEMS_LAYER;
    unsigned char* wl = F.ws + WS_W + (size_t)l * W_LAYER;
    const size_t offGU = (size_t)l * DM * FF;
    const float* W; const float* gn; bf16* dst; int ldw, nblk, K, up = 0, gated = 0;
    if (r < 3 * TR_NGU) {
        if (r < 2 * TR_NGU) { up = r >= TR_NGU; r -= up * TR_NGU; W = in_ptr(up ? 5 : 4) + offGU; ldw = FF; nblk = FF / 64; gn = in_ptr(1) + l * DM; K = DM; dst = (bf16*)(wl + W_GU0); gated = 1; }
        else { r -= 2 * TR_NGU; W = in_ptr(6) + offGU; ldw = DM; nblk = DM / 64; gn = nullptr; K = FF; dst = (bf16*)(wl + W_D0); }
    } else if (r < 3 * TR_NGU + TR_NIN + TR_NOUT) {
        const int kind = l % 3, j = l / 3; r -= 3 * TR_NGU;
        if (r < TR_NIN) { ldw = kind == 0 ? FOXN : NQKV; W = (kind == 0 ? in_ptr(10) : kind == 1 ? in_ptr(15) : in_ptr(18)) + (size_t)j * DM * ldw; nblk = NQKV / 64; gn = in_ptr(2) + l * DM; K = DM; dst = (bf16*)(wl + W_IN); }
        else { r -= TR_NIN; W = (kind == 0 ? in_ptr(14) : kind == 1 ? in_ptr(17) : in_ptr(19)) + (size_t)j * DM * DM; ldw = DM; nblk = DM / 64; gn = nullptr; K = DM; dst = (bf16*)(wl + W_OUT); }
    } else { r -= 3 * TR_NGU + TR_NIN + TR_NOUT;
        if (r < 2 * TR_NGU) { up = r >= TR_NGU; r -= up * TR_NGU; W = in_ptr(up ? 8 : 7) + offGU; ldw = FF; nblk = FF / 64; gn = in_ptr(3) + l * DM; K = DM; dst = (bf16*)(wl + W_GU1); gated = 1; }
        else { r -= 2 * TR_NGU; W = in_ptr(9) + offGU; ldw = DM; nblk = DM / 64; gn = nullptr; K = FF; dst = (bf16*)(wl + W_D1); }
    }
    const int kb = r / nblk, nb = r - kb * nblk, k0 = kb * 64, n0 = nb * 64;
    const int row = gated ? (((n0 >> 7) << 8) + (n0 & 127) + up * 128) : n0;
    d.src = W + (size_t)k0 * ldw + n0; d.gain = gn ? gn + k0 : nullptr; d.dst = dst + (size_t)row * K + k0; d.ldw = ldw; d.K = K;
}
__device__ __forceinline__ void tr_load(const TrDesc& d, f32x4 (&v)[16], f32x4 (&gv)[2], int lane) {
    const float* p = d.src + (size_t)(lane >> 4) * d.ldw + (lane & 15) * 4;
#pragma unroll
    for (int j = 0; j < 16; ++j) v[j] = __builtin_nontemporal_load((const f32x4*)(p + (size_t)(4 * j) * d.ldw));
    if (d.gain) { gv[0] = *(const f32x4*)(d.gain + 8 * (lane & 7)); gv[1] = *(const f32x4*)(d.gain + 8 * (lane & 7) + 4); }
    else { gv[0] = f32x4{1.f, 1.f, 1.f, 1.f}; gv[1] = gv[0]; }
}
__device__ __forceinline__ void tr_finish(const TrDesc& d, const f32x4 (&v)[16], const f32x4 (&gv)[2], LAS float* scr, int lane) {
    const int r0 = lane >> 4, c4 = (lane & 15) * 4;
#pragma unroll
    for (int j = 0; j < 16; ++j)
#pragma unroll
        for (int e = 0; e < 4; ++e) scr[(4 * j + r0) * 65 + c4 + e] = v[j][e];
    LDS_WAIT(); asm volatile("" ::: "memory");
    const int c = lane & 7;
#pragma unroll
    for (int j = 0; j < 8; ++j) { const int n = (lane >> 3) + 8 * j; const LAS float* s = scr + (8 * c) * 65 + n;
        v4u o; o.x = pg8::cvt_pk_bf16(s[0 * 65] * gv[0][0], s[1 * 65] * gv[0][1]); o.y = pg8::cvt_pk_bf16(s[2 * 65] * gv[0][2], s[3 * 65] * gv[0][3]);
        o.z = pg8::cvt_pk_bf16(s[4 * 65] * gv[1][0], s[5 * 65] * gv[1][1]); o.w = pg8::cvt_pk_bf16(s[6 * 65] * gv[1][2], s[7 * 65] * gv[1][3]);
        __builtin_nontemporal_store(o, (GAS v4u*)(d.dst + (size_t)n * d.K + 8 * c)); }
    LDS_WAIT(); asm volatile("" ::: "memory");
}
#define TR_WAIT_OLDER(dn, has) do { if (!(has)) asm volatile("s_waitcnt vmcnt(0)" ::: "memory"); else if ((dn).gain) asm volatile("s_waitcnt vmcnt(18)" ::: "memory"); else asm volatile("s_waitcnt vmcnt(16)" ::: "memory"); } while (0)
__device__ __forceinline__ void convert_range(Frame& F, int g0, int g1, int first, int stride) {
    const int lane = fresh_tid() & 63;
    LAS float* scr = (LAS float*)(F.lds + F.wave * TR_SCR_BYTES);
    const int it_end = g1 < TR_ITEMS ? g1 : TR_ITEMS;
    int it = g0 + first;
    if (it >= it_end) return;
    TrDesc dA, dB; f32x4 vA[16], vB[16], gA[2], gB[2];
    tr_decode(F, it, dA); tr_load(dA, vA, gA, lane);
    for (;;) {
        it += stride; const bool hasB = it < it_end;
        if (hasB) { tr_decode(F, it, dB); tr_load(dB, vB, gB, lane); }
        TR_WAIT_OLDER(dB, hasB); tr_finish(dA, vA, gA, scr, lane);
        if (!hasB) break;
        it += stride; const bool hasA = it < it_end;
        if (hasA) { tr_decode(F, it, dA); tr_load(dA, vA, gA, lane); }
        TR_WAIT_OLDER(dA, hasA); tr_finish(dB, vB, gB, scr, lane);
        if (!hasA) break;
    }
}
__device__ __forceinline__ void p_prologue(Frame& F, bool all_layers) {
    convert_range(F, 0, all_layers ? TR_ITEMS : TR_PRO, F.gw, F.ngw);
    const int lane = fresh_tid() & 63;
    for (int i = F.gw * 64 + lane; i < 2 * NH * DM; i += F.ngw * 64) { const int j = i / (NH * DM), r = i - j * NH * DM, h = r / DM, k = r - h * DM;
        WSP(bf16, WS_WFT)[i] = (bf16)f2bf(in_ptr(2)[(size_t)(3 * j) * DM + k] * in_ptr(10)[((size_t)j * DM + k) * FOXN + NQKV + h]); }
    const float* xin = in_ptr(0);
    for (int m = F.gw; m < SEQ; m += F.ngw) {
        const GAS f32x4* xr = (const GAS f32x4*)(xin + (size_t)m * DM) + lane;
        GAS v2u* xb = (GAS v2u*)(WSP(bf16, WS_XB) + (size_t)m * DM) + lane; float s = 0.f;
#pragma unroll
        for (int j = 0; j < 8; ++j) { const f32x4 v = xr[64 * j]; s += (v.x * v.x + v.y * v.y) + (v.z * v.z + v.w * v.w);
            v2u w; w.x = pk2(v.x, v.y); w.y = pk2(v.z, v.w); xb[64 * j] = w; }
        s = wave_sum(s);
        if (lane == 0) WSP(pg8::u64_t, WS_SS)[m] = (pg8::u64_t)(s * pg8::SS_FIX);
    }
}
__device__ __forceinline__ void p_fgate(Frame& F, int l, const pg8::u64_t* ss) {
    const int j = l / 3; const bf16* WT = WSP(bf16, WS_WFT) + (size_t)j * NH * DM; const float* bf = in_ptr(11) + j * NH;
    const int tid = fresh_tid(), lane = tid & 63, rg = F.wave >> 2, kq = F.wave & 3;
    LAS float* red = (LAS float*)F.lds;
    for (int tb = blockIdx.x; tb < SEQ / 32; tb += gridDim.x) {
        const bf16* xa = WSP(bf16, WS_XB) + (size_t)(tb * 32 + rg * 16 + (lane & 15)) * DM + kq * 512 + (lane >> 4) * 8;
        const bf16* wb = WT + (size_t)(lane & 15) * DM + kq * 512 + (lane >> 4) * 8;
        pg8::bf16x8 a[16], b[16];
#pragma unroll
        for (int s = 0; s < 16; ++s) { a[s] = *(const pg8::bf16x8*)(xa + s * 32); b[s] = *(const pg8::bf16x8*)(wb + s * 32); }
        f32x4 acc = {0.f, 0.f, 0.f, 0.f};
#pragma unroll
        for (int s = 0; s < 16; ++s) acc = __builtin_amdgcn_mfma_f32_16x16x32_bf16(a[s], b[s], acc, 0, 0, 0);
        *(LAS f32x4*)(red + (F.wave * 64 + lane) * 4) = acc;
        __syncthreads();
        { const int rg2 = tid >> 8, h = (tid >> 4) & 15, tk = tid & 15, t = tb * 32 + rg2 * 16 + tk;
          const LAS float* p = red + ((rg2 * 4) * 64 + (tk >> 2) * 16 + h) * 4 + (tk & 3);
          const float s = (p[0] + p[256]) + (p[512] + p[768]);
          const float rs = 1.0f / sqrtf((float)ss[t] * (pg8::SS_UNFIX / DM) + EPS);
          const float u = s * rs + bf[h];
          WSP(float, WS_LOGF)[(size_t)h * SEQ + t] = fminf(u, 0.f) - log1pf(expf(-fabsf(u))); }
        __syncthreads();
    }
}
__device__ __forceinline__ void p_conv(Frame& F, int l) {
    const float* ck = in_ptr(16) + (size_t)(l / 3) * 3 * DM; const int lane = fresh_tid() & 63;
    const bf16* Q = WSP(bf16, WS_QKV); bf16* O = WSP(bf16, WS_OB);
    for (int idx = F.gw * 64 + lane; idx < (SEQ / 16) * (DM / 8); idx += F.ngw * 64) {
        const int c = (idx & 255) * 8, t0 = (idx >> 8) * 16;
        float k0[8], k1[8], k2[8], p1[8], p2[8];
#pragma unroll
        for (int e8 = 0; e8 < 8; ++e8) { k0[e8] = ck[c + e8]; k1[e8] = ck[DM + c + e8]; k2[e8] = ck[2 * DM + c + e8]; p1[e8] = 0.f; p2[e8] = 0.f; }
        if (t0 > 0) {
#pragma unroll
            for (int d = 2; d >= 1; --d) { const bf16* r = Q + (size_t)(t0 - d) * NQKV + c; const v4u cg = *(const v4u*)(r + DM), uu = *(const v4u*)(r + 2 * DM);
#pragma unroll
                for (int e4 = 0; e4 < 4; ++e4) { const float a = bf_lo(cg[e4]) * bf_lo(uu[e4]), b2 = bf_hi(cg[e4]) * bf_hi(uu[e4]);
                    if (d == 2) { p2[2 * e4] = a; p2[2 * e4 + 1] = b2; } else { p1[2 * e4] = a; p1[2 * e4 + 1] = b2; } } } }
#pragma unroll 4
        for (int i = 0; i < 16; ++i) { const bf16* r = Q + (size_t)(t0 + i) * NQKV + c;
            const v4u bg = *(const v4u*)r, cg = *(const v4u*)(r + DM), uu = *(const v4u*)(r + 2 * DM); float y[8];
#pragma unroll
            for (int e4 = 0; e4 < 4; ++e4) { const float a = bf_lo(cg[e4]) * bf_lo(uu[e4]), b2 = bf_hi(cg[e4]) * bf_hi(uu[e4]);
                y[2 * e4] = bf_lo(bg[e4]) * (k0[2 * e4] * p2[2 * e4] + k1[2 * e4] * p1[2 * e4] + k2[2 * e4] * a);
                y[2 * e4 + 1] = bf_hi(bg[e4]) * (k0[2 * e4 + 1] * p2[2 * e4 + 1] + k1[2 * e4 + 1] * p1[2 * e4 + 1] + k2[2 * e4 + 1] * b2);
                p2[2 * e4] = p1[2 * e4]; p2[2 * e4 + 1] = p1[2 * e4 + 1]; p1[2 * e4] = a; p1[2 * e4 + 1] = b2; }
            v4u o; o.x = pk2(y[0], y[1]); o.y = pk2(y[2], y[3]); o.z = pk2(y[4], y[5]); o.w = pk2(y[6], y[7]);
            *(v4u*)(O + (size_t)(t0 + i) * DM + c) = o; }
    }
}
template <int KIND>
__device__ __forceinline__ void p_attn_naive(Frame& F) {
    const int lane = fresh_tid() & 63;
    for (int p = F.gw; p < SEQ * NH; p += F.ngw) {
        const int h = p & 15, t = p >> 4;
        const bf16* Qr = WSP(bf16, WS_QKV) + (size_t)t * NQKV + h * HD; const bf16* Kh = WSP(bf16, WS_QKV) + DM + h * HD; const bf16* Vh = WSP(bf16, WS_QKV) + 2 * DM + h * HD + 2 * lane;
        LAS float* q = (LAS float*)(F.lds + F.wave * 1024);
        { const unsigned w = *(const unsigned*)(Qr + 2 * lane); asm volatile("" ::: "memory"); q[2 * lane] = bf_lo(w); q[2 * lane + 1] = bf_hi(w); LDS_WAIT(); asm volatile("" ::: "memory"); }
        float o0 = 0.f, o1 = 0.f;
        if (KIND == 0) {
            const float* cn = WSP(float, WS_CNEG) + (size_t)h * SEQ; const float cnt = cn[t];
            float m = -1e30f, lsum = 0.f; const int nt = t / 64 + 1;
            for (int jt = 0; jt < nt; ++jt) { asm volatile("" ::: "memory"); const int s0 = jt * 64, s = s0 + lane; const bf16* kr = Kh + (size_t)s * NQKV; float dot = 0.f;
#pragma unroll
                for (int c = 0; c < 16; ++c) { const v4u w = *(const v4u*)(kr + 8 * c);
#pragma unroll
                    for (int e = 0; e < 4; ++e) dot += q[8 * c + 2 * e] * bf_lo(w[e]) + q[8 * c + 2 * e + 1] * bf_hi(w[e]); }
                float sc = dot + (cn[s] - cnt); if (s > t) sc = -__builtin_inff();
                const float mn = fmaxf(m, wave_max(sc)); const float pr = exp2f(sc - mn), al = exp2f(m - mn);
                lsum = lsum * al + wave_sum(pr); o0 *= al; o1 *= al; m = mn;
#pragma unroll 8
                for (int jj = 0; jj < 64; ++jj) { const float pj = __int_as_float(__builtin_amdgcn_readlane(__float_as_int(pr), jj));
                    const unsigned vv = *(const unsigned*)(Vh + (size_t)(s0 + jj) * NQKV); o0 += pj * bf_lo(vv); o1 += pj * bf_hi(vv); } }
            const float il = 1.0f / lsum; o0 *= il; o1 *= il;
        } else {
            float R = 0.f;
            for (int jt = (t - 1) >> 6; jt >= 0 && t > 0 && R > -200.f; --jt) {     asm volatile("" ::: "memory"); const int s0 = jt * 64, s = s0 + lane; const bf16* kr = Kh + (size_t)s * NQKV; float z = 0.f;
#pragma unroll
                for (int c = 0; c < 16; ++c) { const v4u w = *(const v4u*)(kr + 8 * c);
#pragma unroll
                    for (int e = 0; e < 4; ++e) z += q[8 * c + 2 * e] * bf_lo(w[e]) + q[8 * c + 2 * e + 1] * bf_hi(w[e]); }
                const bool valid = s < t;
                const float ls = fminf(z, 0.f) - log2f(1.0f + exp2f(-fabsf(z)));
                const float lom = valid ? ls - z : 0.f;
                float inc = lom;
#pragma unroll
                for (int o = 1; o < 64; o <<= 1) { const float tv = __shfl_down(inc, o); if (lane + o < 64) inc += tv; }
                const float a = valid ? exp2f(ls + R + (inc - lom)) : 0.f;
                R += __int_as_float(__builtin_amdgcn_readlane(__float_as_int(inc), 0));
#pragma unroll 8
                for (int jj = 0; jj < 64; ++jj) { const float pj = __int_as_float(__builtin_amdgcn_readlane(__float_as_int(a), jj));
                    const unsigned vv = *(const unsigned*)(Vh + (size_t)(s0 + jj) * NQKV); o0 += pj * bf_lo(vv); o1 += pj * bf_hi(vv); } }
        }
        *(unsigned*)(WSP(bf16, WS_OB) + (size_t)t * DM + h * HD + 2 * lane) = pk2(o0, o1);
    }
}

struct Args { const float* in[20]; float* out; unsigned char* ws; int ph_lo, ph_hi; };
__global__ void __launch_bounds__(NWAVES * 64, 2) mk_fwd(Args args) {
    extern __shared__ __attribute__((aligned(16))) unsigned char lds[];
    Frame F;
    F.lds = (LAS unsigned char*)lds;
    F.wave = __builtin_amdgcn_readfirstlane((int)threadIdx.x >> 6);
    F.gw = blockIdx.x * NWAVES + F.wave; F.ngw = gridDim.x * NWAVES;
    F.X = args.out; F.ws = args.ws;
    for (int u = threadIdx.x; u < (LDS_BYTES - LDSCTL_OFF) / 4; u += NWAVES * 64) ((LAS unsigned*)(F.lds + LDSCTL_OFF))[u] = 0u;
    __syncthreads();
    const int lo = args.ph_lo, hi = args.ph_hi;
    unsigned* barw = (unsigned*)(args.ws + WS_CTL) + CW_BAR;
    XcdBarrier bar; bar.bar = barw; bar.x = 0; bar.st = nullptr; bar.wave = (unsigned)F.wave;
    if (hi - lo > 1) bar = xcd_barrier_post(barw, (volatile LAS unsigned*)(F.lds + MISC_OFF) + 8, (unsigned)F.wave);
    const int G = gridDim.x, bid = blockIdx.x;
    const bool inphase_conv = (G == 256);
    int ph = 0;
#define RUN() (lo <= ph && ph < hi)
#define SEAM() do { if (lo <= ph && ph + 1 < hi) { if (((MK_PROBE >> 9) & 1) && MK_TID(F.wave) == 0) { asm volatile("s_waitcnt vmcnt(0)" ::: "memory"); __builtin_amdgcn_fence(__ATOMIC_RELEASE, "agent"); } xcd_barrier(bar); if ((MK_PROBE >> 6) & 1) xcd_barrier(bar); } ++ph; } while (0)

    if (RUN()) { _Pragma("unroll 1") for (int rep = 0; rep < 1 + ((MK_PROBE >> 0) & 1); ++rep) p_prologue(F, !inphase_conv); }
    SEAM();
    for (int f = 0; f < 2 * DEPTH; ++f) {
        const int l = f >> 1, sub = f & 1, nidx = 3 * l + (sub ? 2 : 0);
        unsigned char* wl = args.ws + WS_W + (size_t)l * W_LAYER;
        if (RUN()) {
            pg8::Gemm g{WSP(bf16, WS_XB), (const bf16*)(wl + (sub ? W_GU1 : W_GU0)), SEQ, 2 * FF, DM}; pg8::StaticOrder S; S.init(SEQ, 2 * FF, G, bid);
            pg8::EpiSwiglu E{WSP(bf16, WS_ACT), FF, (MK_RELAUNCH_SCHED == 7 && hi - lo == 1) ? (const pg8::u64_t*)nullptr : WSP(pg8::u64_t, WS_SS) + (size_t)nidx * SEQ, F.lds};
#if MK_STAMP
            if (f == 3 && blockIdx.x == 0 && MK_TID(F.wave) == 0) { unsigned long long* sp = WSP(unsigned long long, WS_CTL + 786432); sp[0] = __builtin_amdgcn_s_memtime(); sp[1] = __builtin_amdgcn_s_memrealtime(); }
#endif
            pg8::gemm_phase<pg8::EpiSwiglu, pg8::StaticOrder, true, true>(F.lds, g, S, E, F.wave);
            if (inphase_conv && bid >= 128) convert_range(F, TR_PRO + f * TR_CHUNK, TR_PRO + (f + 1) * TR_CHUNK, (bid - 128) * NWAVES + F.wave, 128 * NWAVES);
#if MK_STAMP
            if (f == 3 && blockIdx.x == 0 && MK_TID(F.wave) == 0) { unsigned long long* sp = WSP(unsigned long long, WS_CTL + 786432); sp[2] = __builtin_amdgcn_s_memtime(); sp[3] = __builtin_amdgcn_s_memrealtime(); }
#endif
        }
        SEAM();
        if (RUN()) {
            pg8::Gemm g{WSP(bf16, WS_ACT), (const bf16*)(wl + (sub ? W_D1 : W_D0)), SEQ, DM, FF}; pg8::StaticOrder S; S.init(SEQ, DM, G, bid);
            pg8::EpiResid E{(f == 2 * DEPTH - 1) ? F.X : (float*)nullptr, WSP(bf16, WS_XB), WSP(pg8::u64_t, WS_SS) + (size_t)(nidx + 1) * SEQ, 0.5f};
#if (MK_PROBE >> 4) & 1
            { pg8::EpiResid E0{(float*)nullptr, WSP(bf16, WS_XB), WSP(pg8::u64_t, WS_SS) + (size_t)13 * SEQ, 0.0f}; pg8::gemm_phase<pg8::EpiResid, pg8::StaticOrder, true, true>(F.lds, g, S, E0, F.wave); }
#endif
            pg8::gemm_phase<pg8::EpiResid, pg8::StaticOrder, true, true>(F.lds, g, S, E, F.wave);
        }
        SEAM();
        if (sub == 0) {
            const int kind = l % 3; const pg8::u64_t* ssm = WSP(pg8::u64_t, WS_SS) + (size_t)(3 * l + 1) * SEQ;
            if (RUN()) {
                pg8::Gemm g{WSP(bf16, WS_XB), (const bf16*)(wl + W_IN), SEQ, NQKV, DM}; pg8::StaticOrder S; S.init(SEQ, NQKV, G, bid);
                pg8::EpiQKV E{WSP(bf16, WS_QKV), NQKV, ssm, QSCALE, kind == 2 ? DM / 256 : 0, kind == 0 ? in_ptr(12) + (l / 3) * HD : (const float*)nullptr, kind == 0 ? in_ptr(13) + (l / 3) * HD : (const float*)nullptr, (PG8_LAS float*)(F.lds + RING_BYTES)};
                _Pragma("unroll 1") for (int rep = 0; rep < 1 + ((MK_PROBE >> 3) & 1); ++rep) pg8::gemm_phase<pg8::EpiQKV, pg8::StaticOrder, true, true>(F.lds, g, S, E, F.wave);
                if (kind == 0) p_fgate(F, l, ssm);
            }
            SEAM();
            if (kind == 0) {
#if MK_NAIVE_ATTN
                if (RUN()) p_attn_naive<0>(F);
#else
                if (RUN()) { _Pragma("unroll 1") for (int rep = 0; rep < 1 + ((MK_PROBE >> 2) & 1); ++rep) att::attn_phase<0>((char*)lds, WSP(bf16, WS_QKV), WSP(bf16, WS_OB), WSP(float, WS_LOGF), in_ptr(12) + (l / 3) * HD, in_ptr(13) + (l / 3) * HD, F.wave, (hi - lo == 1) ? MK_RELAUNCH_SCHED : 0); }
#endif
                SEAM();
            } else if (kind == 1) {
                if (RUN()) { _Pragma("unroll 1") for (int rep = 0; rep < 1 + ((MK_PROBE >> 8) & 1); ++rep) p_conv(F, l); }
                SEAM();
            } else {
#if MK_NAIVE_ATTN
                if (RUN()) p_attn_naive<2>(F);
#else
                if (RUN()) { _Pragma("unroll 1") for (int rep = 0; rep < 1 + ((MK_PROBE >> 7) & 1); ++rep) att::attn_phase<2>((char*)lds, WSP(bf16, WS_QKV), WSP(bf16, WS_OB), WSP(float, WS_LOGF), (const float*)nullptr, (const float*)nullptr, F.wave); }
#endif
                SEAM();
            }
            if (RUN()) {
                pg8::Gemm g{WSP(bf16, WS_OB), (const bf16*)(wl + W_OUT), SEQ, DM, DM}; pg8::StaticOrder S; S.init(SEQ, DM, G, bid);
                pg8::EpiResid E{(float*)nullptr, WSP(bf16, WS_XB), WSP(pg8::u64_t, WS_SS) + (size_t)(3 * l + 2) * SEQ, 1.0f};
#if (MK_PROBE >> 5) & 1
                { pg8::EpiResid E0{(float*)nullptr, WSP(bf16, WS_XB), WSP(pg8::u64_t, WS_SS) + (size_t)13 * SEQ, 0.0f}; pg8::gemm_phase<pg8::EpiResid, pg8::StaticOrder, true, true>(F.lds, g, S, E0, F.wave); }
#endif
                pg8::gemm_phase<pg8::EpiResid, pg8::StaticOrder, true, true>(F.lds, g, S, E, F.wave);
            }
            SEAM();
        }
    }
#if MK_STAMP
    xcd_barrier(bar);
    if (blockIdx.x == 0 && MK_TID(F.wave) == 0) { const unsigned long long* sp = WSP(unsigned long long, WS_CTL + 786432); const float stamp_dc = (float)(sp[2] - sp[0]), stamp_dr = (float)(sp[3] - sp[1]); F.X[0] = 1000.0f * floorf((MK_STAMP == 1) ? (stamp_dc / stamp_dr * 100.0f / 500.0f)   : (stamp_dc / (6.0f * 32.0f) / 500.0f))  ; }
#endif
#undef RUN
#undef SEAM
}

extern "C" void kernel_launch(void* const* d_in, const int* in_sizes, int n_in, void* d_out, int out_size, void* d_ws, size_t ws_size, hipStream_t stream) {
    static int grid = 0;
    if (grid == 0) {
        if (n_in != 20 || in_sizes[0] != SEQ * DM || out_size != SEQ * DM || ws_size < WS_END) {
            fprintf(stderr, "kernel_launch: unexpected shapes (n_in %d, in0 %d, out %d, ws %zu; need ws >= %zu); nothing launched\n", n_in, n_in > 0 ? in_sizes[0] : -1, out_size, ws_size, (size_t)WS_END); grid = -1; return; }
        int dev = 0, cus = 0, per_cu = 0;
        if (hipGetDevice(&dev) != hipSuccess || hipDeviceGetAttribute(&cus, hipDeviceAttributeMultiprocessorCount, dev) != hipSuccess) { grid = -1; return; }
        if (hipFuncSetAttribute((const void*)mk_fwd, hipFuncAttributeMaxDynamicSharedMemorySize, LDS_BYTES) != hipSuccess) { fprintf(stderr, "kernel_launch: hipFuncSetAttribute failed\n"); grid = -1; return; }
        if (hipOccupancyMaxActiveBlocksPerMultiprocessor(&per_cu, (const void*)mk_fwd, NWAVES * 64, LDS_BYTES) != hipSuccess || per_cu < 1)
            fprintf(stderr, "kernel_launch: note: occupancy query reports %d workgroups per CU\n", per_cu);
        (void)hipGetLastError();
        grid = cus;
    }
    if (grid < 0) return;
    if (hipMemsetAsync((char*)d_ws + WS_CTL, 0, CTL_ZERO_BYTES, stream) != hipSuccess) { fprintf(stderr, "kernel_launch: memset failed\n"); return; }
    Args a{};
    for (int i = 0; i < 20; ++i) a.in[i] = (const float*)d_in[i];
    a.out = (float*)d_out; a.ws = (unsigned char*)d_ws;
#if MK_ONE_LAUNCH
    a.ph_lo = 0; a.ph_hi = N_PHASES;
    hipLaunchKernelGGL(mk_fwd, dim3(grid), dim3(NWAVES * 64), LDS_BYTES, stream, a);
#if MK_RELAUNCH >= 0
    for (int r = 0; r < MK_RELAUNCH_N; ++r) { if (MK_RELAUNCH_SPAN > 1) (void)hipMemsetAsync((char*)d_ws + WS_CTL + CW_BAR * 4, 0, XCD_BAR_WORDS * 4, stream); a.ph_lo = MK_RELAUNCH; a.ph_hi = MK_RELAUNCH + MK_RELAUNCH_SPAN; hipLaunchKernelGGL(mk_fwd, dim3(grid), dim3(NWAVES * 64), LDS_BYTES, stream, a); }
#endif
#else
    for (int p = 0; p < N_PHASES; ++p) { a.ph_lo = p; a.ph_hi = p + 1;
        hipLaunchKernelGGL(mk_fwd, dim3(grid), dim3(NWAVES * 64), LDS_BYTES, stream, a); }
#endif
    const hipError_t le = hipPeekAtLastError();
    if (le != hipSuccess) fprintf(stderr, "kernel_launch: launch failed: %s\n", hipGetErrorName(le));
}
```

```cpp
#include <hip/hip_runtime.h>
#include <cstdio>
#include <cstdint>
#ifndef MK_ONE_LAUNCH
#define MK_ONE_LAUNCH 1
#endif
#ifndef MK_NAIVE_ATTN
#define MK_NAIVE_ATTN 0
#endif
#ifndef MK_PROBE
#define MK_PROBE 0
#endif
#ifndef MK_RELAUNCH
#define MK_RELAUNCH -1
#define MK_RELAUNCH_N 1
#define MK_RELAUNCH_SCHED 0
#define MK_RELAUNCH_SPAN 1
#endif
#ifndef MK_STAMP
#define MK_STAMP 0
#endif
__device__ __forceinline__ int mk_lane_() { unsigned z = 0u; asm volatile("" : "+v"(z)); return (int)__builtin_amdgcn_mbcnt_hi(~0u, __builtin_amdgcn_mbcnt_lo(~0u, z)); }
#define MK_LANE() mk_lane_()
#define MK_TID(wave) ((int)(wave) * 64 + MK_LANE())
namespace pg8 {
#define PG8_LAS __attribute__((address_space(3)))
typedef unsigned short bf16_t;
typedef short bf16x8 __attribute__((ext_vector_type(8)));
typedef float f32x4 __attribute__((ext_vector_type(4)));
typedef unsigned u32x4 __attribute__((ext_vector_type(4)));
constexpr int BM = 256, BK = 64, HALF = 128, HTB = HALF * BK * 2  , STAGE_BYTES = 8 * HTB, NXCD = 8, WGM = 8;

__host__ __device__ __forceinline__ int lds_byte(int r, int c) { const int st = (r >> 4) * 2 + (c >> 5), rr = r & 15, cc = c & 31, ob = rr * 64 + cc * 2; return st * 1024 + (ob ^ (((ob >> 9) & 1) << 5)); }
__host__ __device__ __forceinline__ void stage_rc(int b, int& R, int& C) { const int st = b / 1024, sb = b % 1024, swz = sb ^ (((sb >> 9) & 1) << 5); R = (st >> 1) * 16 + swz / 64; C = (st & 1) * 32 + (swz % 64) / 2; }
__host__ __device__ __forceinline__ int perm32(int rho) { const int n = rho >> 4, i = rho & 15; return 8 * (i >> 2) + 4 * n + (i & 3); }

struct Unit { int pm, pn; };
struct Gemm { const bf16_t* A; const bf16_t* Bt; int M, N, K; };

struct StaticOrder {
    int nM, nN, nwg, G, c, i0, ni;
    __host__ __device__ void init(int M, int N, int G_, int c_) { nM = M / BM; nN = N / BM; nwg = nM * nN; G = G_; c = c_; i0 = 0; ni = 1 << 20; }
    __host__ __device__ bool next(int i, Unit& u) const {
        if (i >= ni) return false;
        const long L = (long)(i + i0) * G + c; if (L >= nwg) return false;
        int wgid = (int)L; { const int q = nwg / NXCD, r = nwg % NXCD, xcd = wgid % NXCD, off = wgid / NXCD; wgid = (xcd < r ? xcd * (q + 1) : r * (q + 1) + (xcd - r) * q) + off; }
        const int nig = WGM * nN, gid = wgid / nig, fm = gid * WGM, gsz = (nM - fm) < WGM ? (nM - fm) : WGM;
        u.pm = fm + ((wgid % nig) % gsz); u.pn = (wgid % nig) / gsz; return true;
    }
    __device__ __forceinline__ void a_ready(const Unit&) const {}
    __device__ __forceinline__ void done(const Unit&) const {}
};


__device__ __forceinline__ unsigned cvt_pk_bf16(float lo, float hi) { unsigned r; asm volatile("v_cvt_pk_bf16_f32 %0, %1, %2" : "=v"(r) : "v"(lo), "v"(hi)); return r; }
constexpr float NORM_EPS = 1e-6f, INV_D = 1.0f / 2048.0f, SS_FIX = 16777216.0f, SS_UNFIX = 1.0f / 16777216.0f;
typedef unsigned long long u64_t;
__device__ __forceinline__ float ss_rstd(const u64_t* ss, int row) { return __builtin_amdgcn_rsqf((float)ss[row] * (SS_UNFIX * INV_D) + NORM_EPS); }
__device__ __forceinline__ float silu_mul(float g, float u) {
    const float e = __builtin_amdgcn_exp2f(g * -1.4426950408889634f);
    return g * u * __builtin_amdgcn_rcpf(1.0f + e);
}
struct EpiSwiglu {
    static constexpr bool PERM = true, AFTER_DRAIN = false;
    bf16_t* O; int ldc; const u64_t* ss;
    __device__ __forceinline__ void operator()(const f32x4 (&acc)[2][2][4][2], const Unit& u, int wr, int wc, int fr, int fq) const {
        const int row0 = u.pm * BM + wr * 64 + fr, col0 = u.pn * HALF + wc * 32 + 8 * fq;
#pragma unroll
        for (int ai = 0; ai < 2; ++ai)
#pragma unroll
            for (int m = 0; m < 4; ++m) { const int row = row0 + ai * HALF + m * 16;
                const float rs = ss ? ss_rstd(ss, row) : 1.0f;
                const f32x4 g0 = acc[ai][0][m][0] * rs, g1 = acc[ai][0][m][1] * rs, u0 = acc[ai][1][m][0] * rs, u1 = acc[ai][1][m][1] * rs;
                u32x4 w; w.x = cvt_pk_bf16(silu_mul(g0[0], u0[0]), silu_mul(g0[1], u0[1])); w.y = cvt_pk_bf16(silu_mul(g0[2], u0[2]), silu_mul(g0[3], u0[3]));
                w.z = cvt_pk_bf16(silu_mul(g1[0], u1[0]), silu_mul(g1[1], u1[1])); w.w = cvt_pk_bf16(silu_mul(g1[2], u1[2]), silu_mul(g1[3], u1[3]));
                *(u32x4*)(O + (size_t)row * ldc + col0) = w; }
    }
};
struct EpiQKV {
    static constexpr bool PERM = true, AFTER_DRAIN = false;
    bf16_t* O; int ldc; const u64_t* ss; float qscale; int qtiles; const float* qg; const float* kg; PG8_LAS float* scr;
    __device__ __forceinline__ void operator()(const f32x4 (&acc)[2][2][4][2], const Unit& u, int wr, int wc, int fr, int fq) const {
        const int row0 = u.pm * BM + wr * 64 + fr, col0 = u.pn * BM + wc * 32 + 8 * fq;
        const float sc = (u.pn < qtiles) ? qscale : 1.0f;
        float rsv[2][4];
#pragma unroll
        for (int ai = 0; ai < 2; ++ai)
#pragma unroll
            for (int m = 0; m < 4; ++m) rsv[ai][m] = ss_rstd(ss, row0 + ai * HALF + m * 16);
        const bool hn = (qg != nullptr) && (u.pn < 16);
        float hs[2][4][2]; f32x4 ga = {1.f, 1.f, 1.f, 1.f}, gb = {1.f, 1.f, 1.f, 1.f};
        if (hn) {
            const float* gn = (u.pn < 8) ? qg : kg; const float post = (u.pn < 8) ? qscale : 1.0f;
            ga = *(const f32x4*)(gn + wc * 32 + 8 * fq); gb = *(const f32x4*)(gn + wc * 32 + 8 * fq + 4);
#pragma unroll
            for (int ai = 0; ai < 2; ++ai)
#pragma unroll
                for (int m = 0; m < 4; ++m)
#pragma unroll
                    for (int bj = 0; bj < 2; ++bj) { const f32x4 v0 = acc[ai][bj][m][0] * rsv[ai][m], v1 = acc[ai][bj][m][1] * rsv[ai][m];
                        float s = ((v0[0] * v0[0] + v0[1] * v0[1]) + (v0[2] * v0[2] + v0[3] * v0[3])) + ((v1[0] * v1[0] + v1[1] * v1[1]) + (v1[2] * v1[2] + v1[3] * v1[3]));
                        s += __shfl_xor(s, 16); s += __shfl_xor(s, 32);
                        if (fq == 0) scr[((ai * HALF + wr * 64 + m * 16 + fr) * 2 + bj) * 4 + wc] = s; }
            asm volatile("s_waitcnt lgkmcnt(0)" ::: "memory"); __builtin_amdgcn_s_barrier(); asm volatile("" ::: "memory");
#pragma unroll
            for (int ai = 0; ai < 2; ++ai)
#pragma unroll
                for (int m = 0; m < 4; ++m)
#pragma unroll
                    for (int bj = 0; bj < 2; ++bj) { const f32x4 p = *(const PG8_LAS f32x4*)(scr + ((ai * HALF + wr * 64 + m * 16 + fr) * 2 + bj) * 4);
                        hs[ai][m][bj] = post * __builtin_amdgcn_rsqf(((p[0] + p[1]) + (p[2] + p[3])) * (1.0f / 128.0f) + NORM_EPS); }
        } else {
#pragma unroll
            for (int ai = 0; ai < 2; ++ai)
#pragma unroll
                for (int m = 0; m < 4; ++m) { hs[ai][m][0] = sc; hs[ai][m][1] = sc; }
        }
#pragma unroll
        for (int ai = 0; ai < 2; ++ai)
#pragma unroll
            for (int m = 0; m < 4; ++m) { const int row = row0 + ai * HALF + m * 16;
#pragma unroll
                for (int bj = 0; bj < 2; ++bj) { const float rs = rsv[ai][m] * hs[ai][m][bj]; const f32x4 v0 = acc[ai][bj][m][0] * rs * ga, v1 = acc[ai][bj][m][1] * rs * gb;
                    u32x4 w; w.x = cvt_pk_bf16(v0[0], v0[1]); w.y = cvt_pk_bf16(v0[2], v0[3]); w.z = cvt_pk_bf16(v1[0], v1[1]); w.w = cvt_pk_bf16(v1[2], v1[3]);
                    *(u32x4*)(O + (size_t)row * ldc + col0 + bj * HALF) = w; } }
    }
};
struct EpiResid {
    static constexpr bool PERM = true, AFTER_DRAIN = false;
    float* OUTF; bf16_t* XB; u64_t* ss_out; float alpha;
    __device__ __forceinline__ void operator()(const f32x4 (&acc)[2][2][4][2], const Unit& u, int wr, int wc, int fr, int fq) const {
        const int row0 = u.pm * BM + wr * 64 + fr, col0 = u.pn * BM + wc * 32 + 8 * fq;
#pragma unroll
        for (int ai = 0; ai < 2; ++ai)
#pragma unroll
            for (int m = 0; m < 4; ++m) { const int row = row0 + ai * HALF + m * 16; const size_t off = (size_t)row * 2048 + col0; float sq = 0.f;
                u32x4 xo[2];
#pragma unroll
                for (int bj = 0; bj < 2; ++bj) xo[bj] = *(const u32x4*)(XB + off + bj * HALF);
#pragma unroll
                for (int bj = 0; bj < 2; ++bj) { f32x4 x0, x1;
#pragma unroll
                    for (int e = 0; e < 2; ++e) { x0[2 * e] = __uint_as_float(xo[bj][e] << 16); x0[2 * e + 1] = __uint_as_float(xo[bj][e] & 0xffff0000u);
                                                  x1[2 * e] = __uint_as_float(xo[bj][2 + e] << 16); x1[2 * e + 1] = __uint_as_float(xo[bj][2 + e] & 0xffff0000u); }
                    x0 = x0 + acc[ai][bj][m][0] * alpha; x1 = x1 + acc[ai][bj][m][1] * alpha;
                    sq += ((x0[0] * x0[0] + x0[1] * x0[1]) + (x0[2] * x0[2] + x0[3] * x0[3])) + ((x1[0] * x1[0] + x1[1] * x1[1]) + (x1[2] * x1[2] + x1[3] * x1[3]));
                    u32x4 w; w.x = cvt_pk_bf16(x0[0], x0[1]); w.y = cvt_pk_bf16(x0[2], x0[3]); w.z = cvt_pk_bf16(x1[0], x1[1]); w.w = cvt_pk_bf16(x1[2], x1[3]);
                    *(u32x4*)(XB + off + bj * HALF) = w;
                    if (OUTF) { *(f32x4*)(OUTF + off + bj * HALF) = x0; *(f32x4*)(OUTF + off + bj * HALF + 4) = x1; } }
                sq += __shfl_xor(sq, 16); sq += __shfl_xor(sq, 32);
                if (fq == 0) __hip_atomic_fetch_add(ss_out + row, (u64_t)(sq * SS_FIX), __ATOMIC_RELAXED, __HIP_MEMORY_SCOPE_AGENT); }
    }
};
template <class Epi, class Sched, bool ALIGN_EPI = false, bool SP2 = false>
__device__ __forceinline__ void gemm_phase(PG8_LAS unsigned char* lds, const Gemm g, const Sched& S, const Epi& E, const int wave_id) {
    int tid_ = MK_TID(wave_id); asm volatile("" : "+v"(tid_));
    const int tid = tid_, wid = __builtin_amdgcn_readfirstlane(tid >> 6), lane = tid & 63, wr = wid >> 2, wc = wid & 3, fr = lane & 15, fq = lane >> 4;
    const int K = g.K, nt = K / BK;
    unsigned voffA[2], voffB[2];
#pragma unroll
    for (int i = 0; i < 2; ++i) { int R, C; stage_rc(tid * 16 + i * 8192, R, C); const int Rb = Epi::PERM ? ((R & ~31) + perm32(R & 31)) : R;
        voffA[i] = (unsigned)(R * K + C) * 2u; voffB[i] = (unsigned)(Rb * K + C) * 2u; }
    const size_t kstep = (size_t)(BK * 2);
    const size_t hstep = (size_t)HALF * K * 2;
    const size_t tstep = 2 * hstep;
    const unsigned ldsw = (unsigned)wid * 1024u;
    const int aoff = lds_byte(wr * 64 + fr, fq * 8), boff = lds_byte(wc * 32 + fr, fq * 8);
#define PG8_SA(b, h) (((b) * 2 + (h)) * HTB)
#define PG8_SB(b, h) ((4 + (b) * 2 + (h)) * HTB)
#define PG8_STAGE(bufoff, gbase, voff) do { _Pragma("unroll") for (int _i = 0; _i < 2; ++_i) \
        __builtin_amdgcn_global_load_lds((const unsigned*)((const char*)(gbase) + (voff)[_i]), (PG8_LAS unsigned*)(lds + (bufoff) + ldsw + _i * 8192), 16, 0, 0); } while (0)
#define PG8_LDA(dst, b, h) do { _Pragma("unroll") for (int m = 0; m < 4; ++m) _Pragma("unroll") for (int k = 0; k < 2; ++k) dst[m][k] = *(const PG8_LAS bf16x8*)(lds + PG8_SA(b, h) + aoff + m * 2048 + k * 1024); } while (0)
#define PG8_LDB(dst, b, h) do { _Pragma("unroll") for (int n = 0; n < 2; ++n) _Pragma("unroll") for (int k = 0; k < 2; ++k) dst[n][k] = *(const PG8_LAS bf16x8*)(lds + PG8_SB(b, h) + boff + n * 2048 + k * 1024); } while (0)
#define PG8_MMA(ai, bj, At, Bt) do { __builtin_amdgcn_s_setprio(1); _Pragma("unroll") for (int m = 0; m < 4; ++m) _Pragma("unroll") for (int n = 0; n < 2; ++n) _Pragma("unroll") for (int k = 0; k < 2; ++k) \
        acc[ai][bj][m][n] = __builtin_amdgcn_mfma_f32_16x16x32_bf16(Bt[n][k], At[m][k], acc[ai][bj][m][n], 0, 0, 0); __builtin_amdgcn_s_setprio(0); } while (0)
#define PG8_WAIT_V(n) asm volatile("s_waitcnt vmcnt(" #n ")" ::: "memory")
#define PG8_WAIT_L(n) asm volatile("s_waitcnt lgkmcnt(" #n ")" ::: "memory")
#define PG8_BAR __builtin_amdgcn_s_barrier()
#define PG8_SCHED __builtin_amdgcn_sched_barrier(0)
    Unit cur, nxt; int ui = 0;
    if (!S.next(0, cur)) return;
    f32x4 acc[2][2][4][2];
#pragma unroll
    for (int a = 0; a < 2; ++a)
#pragma unroll
        for (int b = 0; b < 2; ++b)
#pragma unroll
            for (int m = 0; m < 4; ++m)
#pragma unroll
                for (int n = 0; n < 2; ++n) acc[a][b][m][n] = (f32x4){0.f, 0.f, 0.f, 0.f};
    bf16x8 At[4][2], B0[2][2], B1[2][2];
    const char* cA = (const char*)g.A + (size_t)cur.pm * tstep; const char* cB = (const char*)g.Bt + (size_t)cur.pn * tstep;
    S.a_ready(cur);
    if constexpr (SP2) {
        PG8_STAGE(PG8_SB(0, 0), cB, voffB); PG8_STAGE(PG8_SB(0, 1), cB + hstep, voffB); PG8_STAGE(PG8_SA(0, 0), cA, voffA); PG8_STAGE(PG8_SA(0, 1), cA + hstep, voffA);
        if (wr == 1) PG8_BAR;
        PG8_WAIT_V(2); PG8_BAR;
        PG8_STAGE(PG8_SB(1, 0), cB + kstep, voffB); PG8_STAGE(PG8_SA(1, 0), cA + kstep, voffA); PG8_STAGE(PG8_SB(1, 1), cB + hstep + kstep, voffB);
        PG8_WAIT_V(6); PG8_BAR;
    } else {
        PG8_STAGE(PG8_SB(0, 0), cB, voffB); PG8_STAGE(PG8_SA(0, 0), cA, voffA); PG8_STAGE(PG8_SB(0, 1), cB + hstep, voffB); PG8_STAGE(PG8_SA(0, 1), cA + hstep, voffA);
        if (wr == 1) PG8_BAR;
        PG8_WAIT_V(4); PG8_BAR;
        PG8_STAGE(PG8_SB(1, 0), cB + kstep, voffB); PG8_STAGE(PG8_SA(1, 0), cA + kstep, voffA); PG8_STAGE(PG8_SB(1, 1), cB + hstep + kstep, voffB);
        PG8_WAIT_V(6); PG8_BAR;
    }
    for (;;) {
        const bool has_next = S.next(ui + 1, nxt);
        const char* nA = has_next ? (const char*)g.A + (size_t)nxt.pm * tstep : cA; const char* nB = has_next ? (const char*)g.Bt + (size_t)nxt.pn * tstep : cB;
        for (int t = 0; t < nt; t += 2) {
            const bool last = (t == nt - 2);
            const char* a1 = cA + (size_t)(t + 1) * kstep;
            const char* a2 = last ? nA : cA + (size_t)(t + 2) * kstep; const char* b2 = last ? nB : cB + (size_t)(t + 2) * kstep;
            const char* a3 = a2 + kstep; const char* b3 = b2 + kstep;
            if (last && has_next) S.a_ready(nxt);
            if constexpr (SP2) {
            PG8_LDB(B0, 0, 0); PG8_LDB(B1, 0, 1); PG8_SCHED; PG8_LDA(At, 0, 0); PG8_STAGE(PG8_SA(1, 1), a1 + hstep, voffA);
            PG8_WAIT_V(8); PG8_WAIT_L(0); PG8_BAR; PG8_MMA(0, 0, At, B0); PG8_MMA(0, 1, At, B1); PG8_BAR; PG8_SCHED;
            PG8_LDA(At, 0, 1); PG8_STAGE(PG8_SB(0, 0), b2, voffB); PG8_STAGE(PG8_SB(0, 1), b2 + hstep, voffB); PG8_STAGE(PG8_SA(0, 0), a2, voffA);
            PG8_WAIT_V(8); PG8_WAIT_L(0); PG8_BAR; PG8_MMA(1, 0, At, B0); PG8_MMA(1, 1, At, B1); PG8_BAR; PG8_SCHED;
            PG8_LDB(B0, 1, 0); PG8_LDB(B1, 1, 1); PG8_SCHED; PG8_LDA(At, 1, 0); PG8_STAGE(PG8_SA(0, 1), a2 + hstep, voffA);
            PG8_WAIT_V(8); PG8_WAIT_L(0); PG8_BAR; PG8_MMA(0, 0, At, B0); PG8_MMA(0, 1, At, B1); PG8_BAR; PG8_SCHED;
            PG8_LDA(At, 1, 1); PG8_STAGE(PG8_SB(1, 0), b3, voffB); PG8_STAGE(PG8_SB(1, 1), b3 + hstep, voffB); PG8_STAGE(PG8_SA(1, 0), a3, voffA);
            PG8_WAIT_V(8); PG8_WAIT_L(0); PG8_BAR; PG8_MMA(1, 0, At, B0); PG8_MMA(1, 1, At, B1); PG8_BAR; PG8_SCHED;
            } else {
            PG8_LDB(B0, 0, 0); PG8_SCHED; PG8_LDA(At, 0, 0); PG8_STAGE(PG8_SA(1, 1), a1 + hstep, voffA);
            PG8_WAIT_L(8); PG8_BAR; PG8_WAIT_L(0); PG8_MMA(0, 0, At, B0); PG8_BAR; PG8_SCHED;
            PG8_LDB(B1, 0, 1); PG8_STAGE(PG8_SB(0, 0), b2, voffB);
            PG8_BAR; PG8_WAIT_L(0); PG8_MMA(0, 1, At, B1); PG8_BAR;
            PG8_LDA(At, 0, 1); PG8_STAGE(PG8_SA(0, 0), a2, voffA);
            PG8_BAR; PG8_WAIT_L(0); PG8_MMA(1, 0, At, B0); PG8_BAR; PG8_SCHED;
            PG8_STAGE(PG8_SB(0, 1), b2 + hstep, voffB);
            PG8_WAIT_V(6); PG8_BAR; PG8_MMA(1, 1, At, B1); PG8_BAR;
            PG8_LDB(B0, 1, 0); PG8_SCHED; PG8_LDA(At, 1, 0); PG8_STAGE(PG8_SA(0, 1), a2 + hstep, voffA);
            PG8_WAIT_L(8); PG8_BAR; PG8_WAIT_L(0); PG8_MMA(0, 0, At, B0); PG8_BAR; PG8_SCHED;
            PG8_LDB(B1, 1, 1); PG8_STAGE(PG8_SB(1, 0), b3, voffB);
            PG8_BAR; PG8_WAIT_L(0); PG8_MMA(0, 1, At, B1); PG8_BAR;
            PG8_LDA(At, 1, 1); PG8_STAGE(PG8_SA(1, 0), a3, voffA);
            PG8_BAR; PG8_WAIT_L(0); PG8_MMA(1, 0, At, B0); PG8_BAR; PG8_SCHED;
            PG8_STAGE(PG8_SB(1, 1), b3 + hstep, voffB);
            PG8_WAIT_V(6); PG8_BAR; PG8_MMA(1, 1, At, B1); PG8_BAR;
            }
        }
        if constexpr (ALIGN_EPI) { if (wr == 0) PG8_BAR; }
        if constexpr (!Epi::AFTER_DRAIN) { E(acc, cur, wr, wc, fr, fq); S.done(cur); }
        if (!has_next) break;
#pragma unroll
        for (int a = 0; a < 2; ++a)
#pragma unroll
            for (int b = 0; b < 2; ++b)
#pragma unroll
                for (int m = 0; m < 4; ++m)
#pragma unroll
                    for (int n = 0; n < 2; ++n) acc[a][b][m][n] = (f32x4){0.f, 0.f, 0.f, 0.f};
        cur = nxt; cA = nA; cB = nB; ++ui;
        if constexpr (ALIGN_EPI) { if (wr == 1) PG8_BAR; }
    }
    PG8_WAIT_V(0);
    if constexpr (!ALIGN_EPI) { if (wr == 0) PG8_BAR; }
    PG8_BAR;
    if constexpr (Epi::AFTER_DRAIN) { E.fused(acc, cur, wr, wc, fr, fq, lds, wid, lane); S.done(cur); }
#undef PG8_SA
#undef PG8_SB
#undef PG8_STAGE
#undef PG8_LDA
#undef PG8_LDB
#undef PG8_MMA
#undef PG8_WAIT_V
#undef PG8_WAIT_L
#undef PG8_BAR
#undef PG8_SCHED
}
}

namespace att {
typedef unsigned short bf16;
typedef short bf16x8 __attribute__((ext_vector_type(8)));
typedef short s16x4 __attribute__((ext_vector_type(4)));
typedef float f32x16 __attribute__((ext_vector_type(16)));
typedef float f32x4 __attribute__((ext_vector_type(4)));
typedef unsigned u32x4 __attribute__((ext_vector_type(4)));
constexpr int NW = 8, QBLK = 32, KVBLK = 64, QB = NW * QBLK, D = 128, PITCH = 6144, OPITCH = 2048, NQB = 8192 / QB;
constexpr int SHM_V = KVBLK * D * 2, SHM_K = KVBLK * D * 2;
constexpr int OFF_WS = 2 * SHM_V + 2 * SHM_K, OFF_BIAS = OFF_WS + NW * 64 * 4, OFF_FLAG = OFF_BIAS + 512, OFF_CB = 69632  , OFF_SCH = OFF_CB + 8192 * 4  , LIST_CAP = 512, LDS_BYTES = OFF_SCH + (32 + LIST_CAP + 4 + 64) * 4;
static_assert(OFF_FLAG + 128 <= OFF_CB, "attention LDS map");
constexpr int BLK_OVH = 4;
constexpr float THR2 = 8.f;
#define KSWZ(row, colB) ((row) * 256 + ((colB) ^ (((row) & 7) << 4)))
#define SBAR() __builtin_amdgcn_sched_barrier(0)
__device__ __forceinline__ int v_st(int k, int c) { const int kk = (k & ~0xC) | ((k & 4) << 1) | ((k & 8) >> 1); return ((kk >> 3) * 4 + (c >> 5)) * 512 + ((kk & 7) * 32 + (c & 31)) * 2; }
__device__ __forceinline__ int v_rd_base(int lane) { return ((lane & 3) << 3) | (((lane >> 2) & 3) << 6) | (((lane >> 4) & 1) << 5) | (((lane >> 5) & 1) << 8); }
constexpr int v_rd_off(int d0, int ks, int half) { return d0 * 512 + ks * 4096 + half * 2048; }
__device__ __forceinline__ int crow(int r, int hi) { return (r & 3) + 8 * (r >> 2) + 4 * hi; }
__device__ __forceinline__ unsigned cvtpk(float lo, float hi) { unsigned r; asm volatile("v_cvt_pk_bf16_f32 %0, %1, %2" : "=v"(r) : "v"(lo), "v"(hi)); return r; }
template <int MLIM> __device__ __forceinline__ void mask_tile(f32x16& p0, f32x16& p1, int dq) {
    const float NEG = -__builtin_inff();
#pragma unroll
    for (int r = 0; r < 16; ++r) { const int c = (r & 3) + 8 * (r >> 2);
        if (dq - c < MLIM) p0[r] = NEG;
        if (dq - c - 32 < MLIM) p1[r] = NEG; }
}
__device__ __forceinline__ void partialSM(f32x16& p0, f32x16& p1, float& m_reg, float& alpha) {
    float pmax = p0[0];
#pragma unroll
    for (int r = 1; r < 16; ++r) pmax = fmaxf(pmax, p0[r]);
#pragma unroll
    for (int r = 0; r < 16; ++r) pmax = fmaxf(pmax, p1[r]);
    { auto rr = __builtin_amdgcn_permlane32_swap(__float_as_uint(pmax), __float_as_uint(pmax), false, false);
      pmax = fmaxf(__uint_as_float(rr[0]), __uint_as_float(rr[1])); }
    float mn;
    if (__builtin_expect(__all((pmax - m_reg) <= THR2), 1)) { mn = m_reg; alpha = 1.f; }
    else { mn = fmaxf(m_reg, pmax); alpha = __builtin_amdgcn_exp2f(m_reg - mn); m_reg = mn; }
#pragma unroll
    for (int r = 0; r < 16; ++r) { p0[r] -= mn; p1[r] -= mn; }
#pragma unroll
    for (int r = 0; r < 16; ++r) p0[r] = __builtin_amdgcn_exp2f(p0[r]);
}
#define ATT_PK4(P, B_, OUT) do { unsigned a0 = cvtpk(P[B_+0], P[B_+1]), a1 = cvtpk(P[B_+2], P[B_+3]);                          \
        unsigned b0 = cvtpk(P[B_+4], P[B_+5]), b1 = cvtpk(P[B_+6], P[B_+7]);                                             \
        auto r0 = __builtin_amdgcn_permlane32_swap(a0, b0, false, false); auto r1 = __builtin_amdgcn_permlane32_swap(a1, b1, false, false); \
        u32x4 w = {r0[0], r1[0], r0[1], r1[1]}; OUT = *reinterpret_cast<bf16x8*>(&w); } while (0)
__device__ __forceinline__ void finishSM(f32x16& p0, f32x16& p1, float alpha, float& l_reg, bf16x8& pa0, bf16x8& pa1, bf16x8& pa2, bf16x8& pa3) {
#pragma unroll
    for (int r = 0; r < 16; ++r) p1[r] = __builtin_amdgcn_exp2f(p1[r]);
    float ps = 0;
#pragma unroll
    for (int r = 0; r < 16; ++r) ps += p0[r];
#pragma unroll
    for (int r = 0; r < 16; ++r) ps += p1[r];
    { auto rr = __builtin_amdgcn_permlane32_swap(__float_as_uint(ps), __float_as_uint(ps), false, false);
      ps = __uint_as_float(rr[0]) + __uint_as_float(rr[1]); }
    l_reg = l_reg * alpha + ps;
    ATT_PK4(p0, 0, pa0); ATT_PK4(p0, 8, pa1); ATT_PK4(p1, 0, pa2); ATT_PK4(p1, 8, pa3);
}
typedef float f32x2 __attribute__((ext_vector_type(2)));
__device__ __forceinline__ void pp_softmax(f32x16& p0, f32x16& p1, float& m_reg, float& l_reg, float& alpha, const bool nomax, bf16x8& pa0, bf16x8& pa1, bf16x8& pa2, bf16x8& pa3) {
    float mn = m_reg; alpha = 1.f;
    if (!nomax) {
        float pmax = p0[0];
#pragma unroll
        for (int r = 1; r < 16; ++r) pmax = fmaxf(pmax, p0[r]);
#pragma unroll
        for (int r = 0; r < 16; ++r) pmax = fmaxf(pmax, p1[r]);
        { auto rr = __builtin_amdgcn_permlane32_swap(__float_as_uint(pmax), __float_as_uint(pmax), false, false);
          pmax = fmaxf(__uint_as_float(rr[0]), __uint_as_float(rr[1])); }
        if (!__builtin_expect(__all((pmax - m_reg) <= THR2), 1)) { mn = fmaxf(m_reg, pmax); alpha = __builtin_amdgcn_exp2f(m_reg - mn); m_reg = mn; }
    }
    const f32x2 mm = {mn, mn}; f32x2 s2 = {0.f, 0.f};
#pragma unroll
    for (int r = 0; r < 8; ++r) { f32x2 a = {p0[2 * r], p0[2 * r + 1]}; a -= mm; a[0] = __builtin_amdgcn_exp2f(a[0]); a[1] = __builtin_amdgcn_exp2f(a[1]); s2 += a; p0[2 * r] = a[0]; p0[2 * r + 1] = a[1]; }
#pragma unroll
    for (int r = 0; r < 8; ++r) { f32x2 a = {p1[2 * r], p1[2 * r + 1]}; a -= mm; a[0] = __builtin_amdgcn_exp2f(a[0]); a[1] = __builtin_amdgcn_exp2f(a[1]); s2 += a; p1[2 * r] = a[0]; p1[2 * r + 1] = a[1]; }
    float ps = s2[0] + s2[1];
    { auto rr = __builtin_amdgcn_permlane32_swap(__float_as_uint(ps), __float_as_uint(ps), false, false);
      ps = __uint_as_float(rr[0]) + __uint_as_float(rr[1]); }
    l_reg = l_reg * alpha + ps;
    ATT_PK4(p0, 0, pa0); ATT_PK4(p0, 8, pa1); ATT_PK4(p1, 0, pa2); ATT_PK4(p1, 8, pa3);
}
__device__ __forceinline__ void sb_partial(f32x16& p0, f32x16& p1, float& R, int dq, bool needmask, int hi) {
    float G[8];
#pragma unroll
    for (int j = 0; j < 8; ++j) { float lom[4];
#pragma unroll
        for (int e = 0; e < 4; ++e) { const int r = 4 * (j & 3) + e; const float z = (j < 4) ? p0[r] : p1[r];
            const float ex = __builtin_amdgcn_exp2f(-__builtin_fabsf(z)); const float lg = __builtin_amdgcn_logf(1.0f + ex);
            float ls = fminf(z, 0.f) - lg; float lo = ls - z;
            if (needmask) { const int c = e + 8 * (j & 3) + ((j < 4) ? 0 : 32); if (dq - c < 1) { lo = 0.f; ls = -__builtin_inff(); } }
            lom[e] = lo; if (j < 4) p0[r] = ls; else p1[r] = ls; }
        const float w2 = lom[3], w1 = w2 + lom[2], w0 = w1 + lom[1]; G[j] = w0 + lom[0];
        const int rb = 4 * (j & 3);
        if (j < 4) { p0[rb + 2] += w2; p0[rb + 1] += w1; p0[rb + 0] += w0; } else { p1[rb + 2] += w2; p1[rb + 1] += w1; p1[rb + 0] += w0; }
    }
    float S = R;
#pragma unroll
    for (int j = 7; j >= 0; --j) { auto rr = __builtin_amdgcn_permlane32_swap(__float_as_uint(G[j]), __float_as_uint(G[j]), false, false);
        const float Pn = hi ? __uint_as_float(rr[0]) : __uint_as_float(rr[1]);
        const float above = S + (hi ? 0.f : Pn);
        const int rb = 4 * (j & 3);
#pragma unroll
        for (int e = 0; e < 4; ++e) { if (j < 4) p0[rb + e] += above; else p1[rb + e] += above; }
        S += (hi ? (Pn + G[j]) : (G[j] + Pn)); }
    R = S;
}
__device__ __forceinline__ void sb_finish(f32x16& p0, f32x16& p1, bf16x8& pa0, bf16x8& pa1, bf16x8& pa2, bf16x8& pa3) {
#pragma unroll
    for (int r = 0; r < 16; ++r) { p0[r] = __builtin_amdgcn_exp2f(p0[r]); p1[r] = __builtin_amdgcn_exp2f(p1[r]); }
    ATT_PK4(p0, 0, pa0); ATT_PK4(p0, 8, pa1); ATT_PK4(p1, 0, pa2); ATT_PK4(p1, 8, pa3);
}
template <int KB, int KIND>
__device__ __forceinline__ void qkt(f32x16& p0, f32x16& p1, const char* K_lds, const char* B_lds, int r32, int hi, const bf16x8* qr) {
    if (KIND == 0) { const char* bb = B_lds + KB * 256 + hi * 16;
#pragma unroll
        for (int i = 0; i < 4; ++i) { const f32x4 b0 = *reinterpret_cast<const f32x4*>(bb + i * 32), b1 = *reinterpret_cast<const f32x4*>(bb + 128 + i * 32);
#pragma unroll
            for (int e = 0; e < 4; ++e) { p0[4 * i + e] = b0[e]; p1[4 * i + e] = b1[e]; } } }
    else { p0 = f32x16{}; p1 = f32x16{}; }
    const char* kb[4];
#pragma unroll
    for (int dd = 0; dd < 4; ++dd) kb[dd] = K_lds + KB * SHM_K + KSWZ(r32, (dd * 16 + hi * 8) * 2);
#pragma unroll
    for (int d0 = 0; d0 < 8; ++d0) { const char* a = kb[d0 & 3] + (d0 >> 2) * 128;
        bf16x8 b0 = *reinterpret_cast<const bf16x8*>(a);
        bf16x8 b1 = *reinterpret_cast<const bf16x8*>(a + 32 * 256);
        p0 = __builtin_amdgcn_mfma_f32_32x32x16_bf16(b0, qr[d0], p0, 0, 0, 0);
        p1 = __builtin_amdgcn_mfma_f32_32x32x16_bf16(b1, qr[d0], p1, 0, 0, 0);
        if (d0 & 1) SBAR(); }
}
template <int VB>
__device__ __forceinline__ void pv_tile(f32x16* o, int vb0, bf16x8 pa0, bf16x8 pa1, bf16x8 pa2, bf16x8 pa3) {
#define TRRD(dst, off) asm volatile("ds_read_b64_tr_b16 %0, %1 offset:%2" : "=&v"(dst) : "v"(vb0), "i"(off) : "memory")
#define PV_D0(d0) do { s16x4 l0, l1, l2, l3, h0, h1, h2, h3; constexpr int b_ = VB * SHM_V + v_rd_off(d0, 0, 0); \
        TRRD(l0, b_); TRRD(h0, b_ + 2048); TRRD(l1, b_ + 4096); TRRD(h1, b_ + 6144); TRRD(l2, b_ + 8192); TRRD(h2, b_ + 10240); TRRD(l3, b_ + 12288); TRRD(h3, b_ + 14336); \
        asm volatile("s_waitcnt lgkmcnt(0)" ::: "memory"); SBAR();   \
        o[d0] = __builtin_amdgcn_mfma_f32_32x32x16_bf16(pa0, (bf16x8){l0[0], l0[1], l0[2], l0[3], h0[0], h0[1], h0[2], h0[3]}, o[d0], 0, 0, 0);   \
        o[d0] = __builtin_amdgcn_mfma_f32_32x32x16_bf16(pa1, (bf16x8){l1[0], l1[1], l1[2], l1[3], h1[0], h1[1], h1[2], h1[3]}, o[d0], 0, 0, 0);   \
        o[d0] = __builtin_amdgcn_mfma_f32_32x32x16_bf16(pa2, (bf16x8){l2[0], l2[1], l2[2], l2[3], h2[0], h2[1], h2[2], h2[3]}, o[d0], 0, 0, 0);   \
        o[d0] = __builtin_amdgcn_mfma_f32_32x32x16_bf16(pa3, (bf16x8){l3[0], l3[1], l3[2], l3[3], h3[0], h3[1], h3[2], h3[3]}, o[d0], 0, 0, 0); } while (0)
    PV_D0(0); PV_D0(1); PV_D0(2); PV_D0(3);
#undef PV_D0
#undef TRRD
}
struct BlockRef { const bf16* Q; const bf16* K; const bf16* V; bf16* O; int P0; };
struct Seam { bf16x8 qr[8]; bf16x8 st_v0, st_v1, st_k0, st_k1; f32x4 st_b; };
template <int KIND> __device__ __forceinline__ int first_kb(int P0) { return P0 + QB - KVBLK; }
#define AROW(p, k0, rr) ((p) + (size_t)((k0) + (rr)) * PITCH + sc)
#define VMW() asm volatile("s_waitcnt vmcnt(0)" ::: "memory")
#define VMWN(n) asm volatile("s_waitcnt vmcnt(%0)" :: "i"(n) : "memory")
#define LD8(p) (*reinterpret_cast<const bf16x8*>(p))
#define SLOAD_B(R_, k0) do { if (KIND == 0 && tid < 16) { const f32x4 t_ = *(const f32x4*)(CB_lds + (k0) + 4 * tid); const float cr_ = CB_lds[(R_).P0]; S.st_b = t_ - cr_; } } while (0)
#define SLOAD_H(R_, k0) do { S.st_v0 = LD8(AROW((R_).V, k0, sr)); S.st_v1 = LD8(AROW((R_).V, k0, 32 + sr)); S.st_k0 = LD8(AROW((R_).K, k0, sr)); S.st_k1 = LD8(AROW((R_).K, k0, 32 + sr)); SLOAD_B(R_, k0); } while (0)
#define SWRITE_HK(bf) do { *(bf16x8*)(K_lds + (bf) * SHM_K + kws) = S.st_k0; *(bf16x8*)(K_lds + (bf) * SHM_K + kws + 32 * 256) = S.st_k1; \
                           if (KIND == 0 && tid < 16) *(f32x4*)(B_lds + (bf) * 256 + tid * 16) = S.st_b; } while (0)
#define SWRITE_HV(bf) do { *(bf16x8*)(V_lds + (bf) * SHM_V + vst0) = S.st_v0; *(bf16x8*)(V_lds + (bf) * SHM_V + vst1) = S.st_v1; } while (0)
#define SWRITE_H(bf) do { SWRITE_HV(bf); SWRITE_HK(bf); } while (0)
template <int KIND>
__device__ __forceinline__ void attn_prime(const BlockRef& cur, char* lds, Seam& S, const int tid) {
    const int wid = __builtin_amdgcn_readfirstlane(tid >> 6), lane = tid & 63, r32 = lane & 31, hi = lane >> 5;
    const int sr = tid >> 4, sc = (tid & 15) * 8, kws = KSWZ(sr, sc * 2); char* K_lds = lds + 2 * SHM_V; char* B_lds = lds + OFF_BIAS; const float* CB_lds = (const float*)(lds + OFF_CB);
    const int kb0 = first_kb<KIND>(cur.P0);
#pragma unroll
    for (int d0 = 0; d0 < 8; ++d0) S.qr[d0] = LD8(cur.Q + (size_t)(wid * QBLK + r32) * PITCH + d0 * 16 + hi * 8);
    SLOAD_H(cur, kb0); VMW(); SWRITE_HK(0);
    __syncthreads();
}
template <int KIND>
__device__ __forceinline__ void attn_block(const BlockRef& cur, const BlockRef& nxt, char* lds, Seam& S, const int tid, const int ntiles) {
    constexpr int MLIM = (KIND == 2) ? 1 : 0;
    const int wid = __builtin_amdgcn_readfirstlane(tid >> 6), lane = tid & 63, r32 = lane & 31, hi = lane >> 5;
    const int NT0 = cur.P0 / KVBLK + QB / KVBLK; int NT = ntiles;
    const int kbn = first_kb<KIND>(nxt.P0);
    const int qlo = cur.P0 + wid * QBLK, qm = qlo + r32 - 4 * hi;
    char* V_lds = lds; char* K_lds = lds + 2 * SHM_V; char* B_lds = lds + OFF_BIAS; const float* CB_lds = (const float*)(lds + OFF_CB);
    float* ws = (float*)(lds + OFF_WS) + wid * 64; float* li_l = ws, * al_l = ws + 32;
    float m_reg = -1e30f, l_reg = 0.f, R = 0.f; f32x16 o[4] = {};
    const int sr = tid >> 4, sc = (tid & 15) * 8, vst0 = v_st(sr, sc), vst1 = v_st(32 + sr, sc), kws = KSWZ(sr, sc * 2);
    const int vb0 = (int)(uintptr_t)V_lds + v_rd_base(lane);
#define RESC(a) do { if (KIND == 0) { if (__any((a) < 1.f)) { if (hi == 0) al_l[r32] = (a); asm volatile("s_waitcnt lgkmcnt(0)" ::: "memory");              \
                     for (int d_ = 0; d_ < 4; ++d_) for (int r = 0; r < 16; ++r) o[d_][r] *= al_l[crow(r, hi)]; } } } while (0)
#define KBASE(t) ((NT0 - 1 - (t)) * KVBLK)
#define NEEDM(kb_) ((kb_) + KVBLK - 1 + MLIM > qlo)
#define SM1(PX0, PX1, alX, t) do { const int kb_ = KBASE(t); if (KIND == 0) { if (NEEDM(kb_)) mask_tile<0>(PX0, PX1, qm - kb_); partialSM(PX0, PX1, m_reg, alX); } \
                                   else { sb_partial(PX0, PX1, R, qm - kb_, NEEDM(kb_), hi); sb_finish(PX0, PX1, pa0, pa1, pa2, pa3); } } while (0)
#define SM2(PY0, PY1, alY) do { if (KIND == 0) finishSM(PY0, PY1, alY, l_reg, pa0, pa1, pa2, pa3); } while (0)
    constexpr int NQL = 8;
#define SEAM_K0() do { VMWN(NQL); SWRITE_HK(0); SBAR(); } while (0)
    f32x16 pA0, pA1, pB0, pB1; float alA = 1.f, alB = 1.f; bf16x8 pa0, pa1, pa2, pa3;
    SWRITE_HV(0); SBAR();
    if (NT > 1) SLOAD_H(cur, KBASE(1));
    SBAR(); qkt<0, KIND>(pA0, pA1, K_lds, B_lds, r32, hi, S.qr);
    SM1(pA0, pA1, alA, 0);
    if (NT > 1) { VMW(); SWRITE_H(1); }
    __syncthreads();
#define HALF_STEP(PX0, PX1, alX, PY0, PY1, alY, t, KB, VB, SB, CHK) do {                                                      \
        SBAR(); qkt<KB, KIND>(PX0, PX1, K_lds, B_lds, r32, hi, S.qr);                                             \
        SM2(PY0, PY1, alY); SBAR();                                                           \
        if ((t) + 1 < NT) { SLOAD_H(cur, KBASE((t) + 1)); SBAR(); }                                               \
        pv_tile<VB>(o, vb0, pa0, pa1, pa2, pa3); SM1(PX0, PX1, alX, (t));                                        \
        if (KIND == 2 && (CHK)) { const bool wd_ = __all(R < -160.f); if (lane == 0) flg[wid] = wd_ ? 1 : 0; }            \
        __syncthreads();                                                                                                      \
        if (KIND == 2 && (CHK)) { const int4 f0_ = *(const int4*)flg, f1_ = *(const int4*)(flg + 4);                          \
            done_all = (f0_.x & f0_.y & f0_.z & f0_.w & f1_.x & f1_.y & f1_.z & f1_.w) != 0; }                                \
        if ((t) + 1 < NT) { VMW(); SWRITE_H(SB); }                                                                          \
        RESC(alX); __syncthreads(); } while (0)
    int* flg = (int*)(lds + OFF_FLAG); bool done_all = false;
    for (int t = 1; t + 1 < NT; t += 2) {
        HALF_STEP(pB0, pB1, alB, pA0, pA1, alA, t, 1, 0, 0, false);
        HALF_STEP(pA0, pA1, alA, pB0, pB1, alB, t + 1, 0, 1, 1, true);
        if (KIND == 2 && done_all) NT = t + 3;
    }
    constexpr bool even = true;
    if (even) { SBAR(); qkt<1, KIND>(pB0, pB1, K_lds, B_lds, r32, hi, S.qr); SBAR(); }
    SLOAD_H(nxt, kbn); SBAR();
#pragma unroll
    for (int d0 = 0; d0 < 8; ++d0) S.qr[d0] = LD8(nxt.Q + (size_t)(wid * QBLK + r32) * PITCH + d0 * 16 + hi * 8);
    SBAR();
    SM2(pA0, pA1, alA); SBAR();
    pv_tile<0>(o, vb0, pa0, pa1, pa2, pa3);
    if (even) { SM1(pB0, pB1, alB, NT - 1); __syncthreads(); RESC(alB);
        SM2(pB0, pB1, alB); SBAR(); pv_tile<1>(o, vb0, pa0, pa1, pa2, pa3); }
    SBAR(); SEAM_K0();
    float rli[16];
    if (KIND == 0) { if (hi == 0) li_l[r32] = l_reg; asm volatile("s_waitcnt lgkmcnt(0)" ::: "memory");
#pragma unroll
        for (int r = 0; r < 16; ++r) rli[r] = __builtin_amdgcn_rcpf(li_l[crow(r, hi)]); }
    else {
#pragma unroll
        for (int r = 0; r < 16; ++r) rli[r] = 1.f; }
    bf16* Ow = cur.O + (size_t)(wid * QBLK) * OPITCH;
#pragma unroll
    for (int r = 0; r < 16; ++r) { const int orow = crow(r, hi);
#pragma unroll
        for (int d0 = 0; d0 < 4; ++d0) { const float v = o[d0][r] * rli[r]; const float vn = __shfl_xor(v, 1);
            if ((r32 & 1) == 0) *(unsigned*)(Ow + (size_t)orow * OPITCH + d0 * 32 + r32) = cvtpk(v, vn); } }
    __syncthreads();
#undef RESC
#undef KBASE
#undef NEEDM
#undef SM1
#undef SM2
#undef SEAM_K0
#undef HALF_STEP
}
template <int KIND>
__device__ __forceinline__ void attn_block_pp(const BlockRef& cur, char* lds, const int tid, const int ntiles, const float bq) {
    const int wid = __builtin_amdgcn_readfirstlane(tid >> 6), lane = tid & 63, r32 = lane & 31, hi = lane >> 5, g = wid >> 2;
    const int NT0 = cur.P0 / KVBLK + QB / KVBLK; int NT = ntiles;
    const bool dyn = ntiles > 12;
    const int qlo = cur.P0 + wid * QBLK, qm = qlo + r32 - 4 * hi;
    char* V_lds = lds; char* K_lds = lds + 2 * SHM_V; char* B_lds = lds + OFF_BIAS; const float* CB_lds = (const float*)(lds + OFF_CB);
    float* ws = (float*)(lds + OFF_WS) + wid * 64; float* li_l = ws, * al_l = ws + 32;
    float m_reg = -1e30f, l_reg = 0.f; f32x16 o[4] = {};
    const int sr = tid >> 4, sc = (tid & 15) * 8, vst0 = v_st(sr, sc), vst1 = v_st(32 + sr, sc), kws = KSWZ(sr, sc * 2);
    const int vb0 = (int)(uintptr_t)V_lds + v_rd_base(lane);
    bf16x8 qr[8], sk0[2], sk1[2], sv0[2], sv1[2];
#define KBASE(t) ((NT0 - 1 - (t)) * KVBLK)
#define CLAMPT(t) ((t) < NT ? (t) : NT - 1)
#define LOADK(S_, t) do { const int k0_ = KBASE(CLAMPT(t)); sk0[S_] = LD8(AROW(cur.K, k0_, sr)); sk1[S_] = LD8(AROW(cur.K, k0_, 32 + sr)); } while (0)
#define LOADV(S_, t) do { const int k0_ = KBASE(CLAMPT(t)); sv0[S_] = LD8(AROW(cur.V, k0_, sr)); sv1[S_] = LD8(AROW(cur.V, k0_, 32 + sr)); } while (0)
#define WRITEK(S_, bf, t) do { *(bf16x8*)(K_lds + (bf) * SHM_K + kws) = sk0[S_]; *(bf16x8*)(K_lds + (bf) * SHM_K + kws + 32 * 256) = sk1[S_]; \
        if (tid < 16) { const f32x4 t_ = *(const f32x4*)(CB_lds + KBASE(t) + 4 * tid); const float cr_ = CB_lds[cur.P0]; *(f32x4*)(B_lds + (bf) * 256 + tid * 16) = t_ - cr_; } } while (0)
#define WRITEV(S_, bf) do { *(bf16x8*)(V_lds + (bf) * SHM_V + vst0) = sv0[S_]; *(bf16x8*)(V_lds + (bf) * SHM_V + vst1) = sv1[S_]; } while (0)
#define STAGE(S_, t) do { VMWN(4); if ((t) + 1 + g < NT) WRITEK(S_, ((t) + 1 + g) & 1, (t) + 1 + g); if ((t) + g < NT) WRITEV(S_, ((t) + g) & 1); \
        LOADK(S_, (t) + 3 + g); LOADV(S_, (t) + 2 + g); } while (0)
#define RESC(a) do { if (__any((a) < 1.f)) { if (hi == 0) al_l[r32] = (a); asm volatile("s_waitcnt lgkmcnt(0)" ::: "memory");              \
                     for (int d_ = 0; d_ < 4; ++d_) for (int r = 0; r < 16; ++r) o[d_][r] *= al_l[crow(r, hi)]; } } while (0)
    { const bf16x8 k00 = LD8(AROW(cur.K, KBASE(0), sr)), k01 = LD8(AROW(cur.K, KBASE(0), 32 + sr));
#pragma unroll
      for (int d0 = 0; d0 < 8; ++d0) qr[d0] = LD8(cur.Q + (size_t)(wid * QBLK + r32) * PITCH + d0 * 16 + hi * 8);
      if (g == 0) { LOADK(0, 1); LOADV(0, 0); LOADK(1, 2); LOADV(1, 1); }
      else        { LOADK(1, 1); LOADV(1, 0); LOADK(0, 2); LOADV(0, 1); }
      VMWN(16);
      *(bf16x8*)(K_lds + kws) = k00; *(bf16x8*)(K_lds + kws + 32 * 256) = k01;
      if (tid < 16) { const f32x4 t_ = *(const f32x4*)(CB_lds + KBASE(0) + 4 * tid); const float cr_ = CB_lds[cur.P0]; *(f32x4*)(B_lds + tid * 16) = t_ - cr_; } }
    __syncthreads();
    if (g == 1) { STAGE(1, -1); __syncthreads(); }
    f32x16 p0, p1; bf16x8 pa0, pa1, pa2, pa3; float al = 1.f;
#define MSEG(t, KB, VP) do { __builtin_amdgcn_s_setprio(1); if ((t) > 0) pv_tile<VP>(o, vb0, pa0, pa1, pa2, pa3); SBAR(); qkt<KB, KIND>(p0, p1, K_lds, B_lds, r32, hi, qr); __builtin_amdgcn_s_setprio(0); } while (0)
#define VSEG(S_, t) do { STAGE(S_, t); SBAR(); const int kb_ = KBASE(t); if (kb_ + KVBLK - 1 > qlo) { mask_tile<0>(p0, p1, qm - kb_); asm volatile("" : "+v"(p0), "+v"(p1)); }     const bool nomax_ = __all(bq + (CB_lds[kb_ + KVBLK - 1] - CB_lds[cur.P0]) <= m_reg + THR2); pp_softmax(p0, p1, m_reg, l_reg, al, nomax_, pa0, pa1, pa2, pa3); RESC(al); } while (0)
    float* mfl = (float*)(lds + OFF_FLAG);
#define UPDATE_NT() do { const f32x4 f0_ = *(const f32x4*)mfl, f1_ = *(const f32x4*)(mfl + 4); \
        const float mm_ = fminf(fminf(fminf(f0_[0], f0_[1]), fminf(f0_[2], f0_[3])), fminf(fminf(f1_[0], f1_[1]), fminf(f1_[2], f1_[3]))) - 136.0f - bq + CB_lds[cur.P0]; \
        int lo_ = 12, hi_ = NT;                                                     \
        while (lo_ < hi_) { const int mid_ = (lo_ + hi_) >> 1; if (CB_lds[KBASE(mid_) + KVBLK - 1] < mm_) hi_ = mid_; else lo_ = mid_ + 1; } \
        NT = __builtin_amdgcn_readfirstlane(hi_ + (hi_ & 1)); } while (0)
    for (int t = 0; t < NT; t += 2) {
        if (dyn && t == 8 && g == 1) UPDATE_NT();
        MSEG(t, 0, 1); __syncthreads();
        if (dyn && t == 8 && g == 0) UPDATE_NT();
        VSEG(0, t); __syncthreads();
        MSEG(t + 1, 1, 0); __syncthreads();
        VSEG(1, t + 1);
        if (dyn && t == 6) { float wm_ = m_reg;
#pragma unroll
            for (int o_ = 1; o_ < 32; o_ <<= 1) wm_ = fminf(wm_, __shfl_xor(wm_, o_));
            if (lane == 0) mfl[wid] = wm_; }
        __syncthreads();
    }
#undef UPDATE_NT
    pv_tile<1>(o, vb0, pa0, pa1, pa2, pa3);
    __syncthreads();
    if (g == 0) __syncthreads();
    float rli[16];
    if (hi == 0) li_l[r32] = l_reg; asm volatile("s_waitcnt lgkmcnt(0)" ::: "memory");
#pragma unroll
    for (int r = 0; r < 16; ++r) rli[r] = __builtin_amdgcn_rcpf(li_l[crow(r, hi)]);
    bf16* Ow = cur.O + (size_t)(wid * QBLK) * OPITCH;
#pragma unroll
    for (int r = 0; r < 16; ++r) { const int orow = crow(r, hi);
#pragma unroll
        for (int d0 = 0; d0 < 4; ++d0) { const float v = o[d0][r] * rli[r]; const float vn = __shfl_xor(v, 1);
            if ((r32 & 1) == 0) *(unsigned*)(Ow + (size_t)orow * OPITCH + d0 * 32 + r32) = cvtpk(v, vn); } }
    __syncthreads();
#undef KBASE
#undef CLAMPT
#undef LOADK
#undef LOADV
#undef WRITEK
#undef WRITEV
#undef STAGE
#undef RESC
#undef MSEG
#undef VSEG
}
#undef AROW
#undef VMW
#undef VMWN
#undef LD8
#undef SLOAD_B
#undef SLOAD_H
#undef SWRITE_HK
#undef SWRITE_HV
#undef SWRITE_H
template <int KIND>
__device__ __forceinline__ void attn_phase(char* lds, const bf16* QKV, bf16* OB, const float* LOGF, const float* qg, const float* kg, const int wave_id, const int probe = 0) {
    const int total = 16 * (NQB / 2), stride = gridDim.x;
    const int L0 = blockIdx.x; if (L0 >= total) return;
    int tid = MK_TID(wave_id); asm volatile("" : "+v"(tid));
    int* sch_nt = (int*)(lds + OFF_SCH); int* list = sch_nt + 32; int* pcnt = list + LIST_CAP;
    int cb_head = -1; float bq_head = 3.0e38f;
#define LOAD_CB(H_) do { if (KIND == 0) { const int h_ = (H_); if (h_ != cb_head) { cb_head = h_; \
        float* cbw = (float*)(lds + OFF_CB); float* wt_ = (float*)(lds + OFF_WS); const int lane_ = tid & 63, wv_ = tid >> 6, t0_ = tid * 16; \
        f32x4 lf_[4]; _Pragma("unroll") for (int q_ = 0; q_ < 4; ++q_) lf_[q_] = *(const f32x4*)(LOGF + (size_t)h_ * 8192 + t0_ + 4 * q_); \
        float v_[16]; float run_ = 0.f; _Pragma("unroll") for (int i_ = 0; i_ < 16; ++i_) { run_ += lf_[i_ >> 2][i_ & 3]; v_[i_] = run_; } \
        float inc_ = run_; _Pragma("unroll") for (int o_ = 1; o_ < 64; o_ <<= 1) { const float tv_ = __shfl_up(inc_, o_); if (lane_ >= o_) inc_ += tv_; } \
        __syncthreads(); if (lane_ == 63) wt_[wv_] = inc_; __syncthreads(); \
        float wb_ = 0.f; for (int w_ = 0; w_ < wv_; ++w_) wb_ += wt_[w_]; const float ex_ = wb_ + inc_ - run_; \
        _Pragma("unroll") for (int i_ = 0; i_ < 16; ++i_) cbw[t0_ + i_] = -(ex_ + v_[i_]) * 1.4426950408889634f; \
        __syncthreads(); } } } while (0)
#define PACK_E(h_, qb_, nt_) (((h_) << 16) | ((qb_) << 8) | (nt_))
    if (KIND == 0 && stride == 256) {
        const int lane = tid & 63;
        float mq = fmaxf(__builtin_fabsf(qg[lane]), __builtin_fabsf(qg[lane + 64])), mk = fmaxf(__builtin_fabsf(kg[lane]), __builtin_fabsf(kg[lane + 64]));
#pragma unroll
        for (int o = 1; o < 64; o <<= 1) { mq = fmaxf(mq, __shfl_xor(mq, o)); mk = fmaxf(mk, __shfl_xor(mk, o)); }
        const float Bq = 128.0f * (0.08838834764831845f * 1.4426950408889634f) * mq * mk * 1.01f;
        const float Tcut = -(136.0f + THR2 + 2.0f * Bq); bq_head = Bq;
        float* sch_f = (float*)(pcnt + 4); int* sch_nh = (int*)(sch_f + 32); int* sch_st = sch_nh + 16;
        { const int hh = tid >> 5, jj = tid & 31; float s = 0.f;
#pragma unroll
          for (int i = 0; i < 16; ++i) s += LOGF[(size_t)hh * 8192 + jj * 256 + i * 16 + 7];
#pragma unroll
          for (int o = 1; o < 32; o <<= 1) s += __shfl_xor(s, o);
          if (jj == 0) sch_f[hh] = -s * (1.4426950408889634f / 512.0f); }
        __syncthreads();
        if (tid < 16) { const float rate = fmaxf(sch_f[tid], 1e-6f); float cutf = -Tcut / (rate * 64.0f) + 5.0f; cutf = fminf(fmaxf(cutf, 4.0f), 128.0f); const int cut = (int)cutf;
            const int ovh_ = probe >= 100 ? probe - 100 : BLK_OVH;
            int W = 0; for (int qb = 0; qb < NQB; ++qb) { const int nt0 = 4 * qb + 4; W += (nt0 < cut ? nt0 : cut) + ovh_; }
            sch_f[16 + tid] = (float)W; }
        __syncthreads();
        if (wave_id == 0) {
            const int hh = lane & 15; const float Wf = sch_f[16 + hh];
            float tot = Wf;
#pragma unroll
            for (int o = 1; o < 16; o <<= 1) tot += __shfl_xor(tot, o);
            int nn = (int)(Wf * 256.0f / tot + 0.5f); nn = nn < 1 ? 1 : (nn > NQB ? NQB : nn);
            int s = nn;
#pragma unroll
            for (int o = 1; o < 16; o <<= 1) s += __shfl_xor(s, o);
            while (s != 256) { const bool up = s < 256; int key = (up && nn >= NQB) ? -1 : ((nn << 4) | (15 - hh)), km = key;
#pragma unroll
                for (int o = 1; o < 16; o <<= 1) { const int t_ = __shfl_xor(km, o); km = t_ > km ? t_ : km; }
                if (km < 0) break;
                if (key == km) nn += up ? 1 : -1;
                s += up ? 1 : -1; }
            int st = nn;
#pragma unroll
            for (int o = 1; o < 16; o <<= 1) { const int t_ = __shfl_up(st, o, 16); if (hh >= o) st += t_; }
            if (lane < 16) { sch_nh[hh] = nn; sch_st[hh] = st - nn; } }
        __syncthreads();
        const int v = (L0 & 7) * 32 + (L0 >> 3);
        int h = 0; for (int hh = 1; hh < 16; ++hh) if (v >= sch_st[hh]) h = hh;
        h = __builtin_amdgcn_readfirstlane(h);
        const int w = v - __builtin_amdgcn_readfirstlane(sch_st[h]), nb = __builtin_amdgcn_readfirstlane(sch_nh[h]);
        if (w >= nb) return;
        LOAD_CB(h);
        if (tid < NQB) { const float* cb = (const float*)(lds + OFF_CB); const int nt0 = 4 * tid + 4; const float thr = cb[tid * QB] + Tcut;
            int lo = 0, hi = nt0;
            while (lo < hi) { const int mid = (lo + hi) >> 1; if (cb[64 * mid + 63] < thr) lo = mid + 1; else hi = mid; }
            int nt = nt0 - lo; nt += nt & 1; if (nt < 4) nt = 4; sch_nt[tid] = nt; }
        __syncthreads();
        if (wave_id == 0) {
            int key = lane < NQB ? (((sch_nt[lane] + BLK_OVH) << 6) | lane) : -1;
#pragma unroll
            for (int k = 2; k <= 64; k <<= 1)
#pragma unroll
                for (int j = k >> 1; j > 0; j >>= 1) { const int other = __shfl_xor(key, j); const bool up = ((lane & k) == 0), lower = ((lane & j) == 0);
                    const bool takemax = (lower == up); key = takemax ? (other > key ? other : key) : (other < key ? other : key); }
            int cnt = 0;
            for (int r = 0; r * nb < NQB; ++r) { const int p = r * nb + ((r & 1) ? nb - 1 - w : w);
                if (p < NQB) { const int kp = __builtin_amdgcn_readlane(key, p); if (lane == 0) list[cnt] = PACK_E(h, kp & 63, (kp >> 6) - BLK_OVH); ++cnt; } }
            if (lane == 0) *pcnt = cnt;
        }
        __syncthreads();
    } else {
        if (tid == 0) { int n = 0;
            for (int Lx = L0; Lx < total && n + 2 <= LIST_CAP; Lx += stride) { const int h = (Lx & 7) * 2 + ((Lx >> 3) >> 4), x = (Lx >> 3) & 15;
                list[n++] = PACK_E(h, x, 4 * x + 4); list[n++] = PACK_E(h, NQB - 1 - x, 4 * (NQB - 1 - x) + 4); }
            *pcnt = n; }
        __syncthreads();
    }
    const int n = __builtin_amdgcn_readfirstlane(*pcnt);
    if (n <= 0 || probe == 1) return;
#define ENT_REF(e_, ref) do { const int h_ = (e_) >> 16, qb_ = ((e_) >> 8) & 255; \
        ref.Q = QKV + (size_t)qb_ * QB * PITCH + h_ * D; ref.K = QKV + 2048 + h_ * D; ref.V = QKV + 4096 + h_ * D; ref.O = OB + (size_t)qb_ * QB * OPITCH + h_ * D; \
        ref.P0 = qb_ * QB; } while (0)
    if (KIND == 0) {
        for (int i = 0; i < n; ++i) { const int e0 = __builtin_amdgcn_readfirstlane(list[i]);
            LOAD_CB(e0 >> 16);
            BlockRef cur; ENT_REF(e0, cur);
            int ntl = e0 & 255; if (probe >= 4 && ntl > probe) ntl = probe;
            attn_block_pp<KIND>(cur, lds, tid, ntl, bq_head); }
        return;
    }
    int e = __builtin_amdgcn_readfirstlane(list[0]);
    LOAD_CB(e >> 16);
    BlockRef cur; ENT_REF(e, cur);
    Seam S; S.st_b = f32x4{0.f, 0.f, 0.f, 0.f};
    attn_prime<KIND>(cur, lds, S, tid);
    for (int i = 0;; ++i) {
        const bool last = i + 1 >= n;
        const int en = last ? e : __builtin_amdgcn_readfirstlane(list[i + 1]);
        const bool chain = !last && (KIND != 0 || (en >> 16) == cb_head);
        BlockRef nxt; if (!chain) nxt = cur; else ENT_REF(en, nxt);
        attn_block<KIND>(cur, nxt, lds, S, tid, e & 255);
        if (last) break;
        if (chain) cur = nxt; else { ENT_REF(en, cur); LOAD_CB(en >> 16); attn_prime<KIND>(cur, lds, S, tid); }
        e = en;
    }
#undef ENT_REF
#undef PACK_E
#undef LOAD_CB
}
#undef KSWZ
#undef SBAR
#undef ATT_PK4
}

constexpr int NWAVES = 8;
constexpr int SEQ = 8192, DM = 2048, FF = 5632, NH = 16, HD = 128, DEPTH = 4, NQKV = 3 * DM, FOXN = 3 * DM + NH;
constexpr float LOG2E = 1.4426950408889634f;
constexpr float QSCALE = 0.08838834764831845f * LOG2E;
constexpr float EPS = 1e-6f;
constexpr size_t MiB = 1u << 20;
constexpr size_t WS_CTL = 0, CTL_ZERO_BYTES = 2 * MiB;
constexpr size_t WS_SS = 1 * MiB;
constexpr size_t WS_CNEG = 2 * MiB;
constexpr size_t WS_LOGF = 3 * MiB;
constexpr size_t WS_WFT = 3 * MiB + 512 * 1024;
constexpr size_t WS_XB = 4 * MiB;
constexpr size_t WS_QKV = 36 * MiB;
constexpr size_t WS_OB = 132 * MiB;
constexpr size_t WS_ACT = 164 * MiB;
constexpr size_t WS_W = 256 * MiB, W_LAYER = 164 * MiB;
constexpr size_t W_GU0 = 0, W_D0 = 44 * MiB, W_GU1 = 66 * MiB, W_D1 = 110 * MiB, W_IN = 132 * MiB, W_OUT = 156 * MiB;
constexpr size_t WS_END = WS_W + DEPTH * W_LAYER;
constexpr int CW_BAR = 4096;
constexpr int RING_BYTES = 131072, LDS_BYTES = 147456, LDSCTL_OFF = LDS_BYTES - 512, MISC_OFF = LDSCTL_OFF + 320;
constexpr int N_PHASES = 29;

#define GAS __attribute__((address_space(1)))
#define LAS __attribute__((address_space(3)))
typedef unsigned short bf16;
typedef unsigned v4u __attribute__((ext_vector_type(4)));
typedef unsigned v2u __attribute__((ext_vector_type(2)));
typedef float f32x4 __attribute__((ext_vector_type(4)));
#define LDS_WAIT() asm volatile("s_waitcnt lgkmcnt(0)" ::: "memory")
#define VM_WAIT() asm volatile("s_waitcnt vmcnt(0)" ::: "memory")
__device__ __forceinline__ unsigned f2bf(float f) { unsigned u = __builtin_bit_cast(unsigned, f); return (u + 0x7fffu + ((u >> 16) & 1u)) >> 16; }
__device__ __forceinline__ unsigned pk2(float lo, float hi) { return f2bf(lo) | (f2bf(hi) << 16); }
__device__ __forceinline__ float bf_lo(unsigned w) { return __uint_as_float(w << 16); }
__device__ __forceinline__ float bf_hi(unsigned w) { return __uint_as_float(w & 0xffff0000u); }

#define XB_TMO      128
#define XB_XCNT(j)  (256  + 64 * (j))
#define XB_XSUB(j)  (1280 + 64 * (j))
#define XB_XGEN(j)  (2304 + 64 * (j))
#define XB_TOP      3328
#define XB_TOPGEN   3392
#define XCD_BAR_WORDS 3456
#define XB_SPIN_CAP (1u << 18)

__device__ __forceinline__ unsigned xb_ld(unsigned* p)              { return __hip_atomic_load(p, __ATOMIC_RELAXED, __HIP_MEMORY_SCOPE_AGENT); }
__device__ __forceinline__ unsigned xb_add(unsigned* p, unsigned v) { return __hip_atomic_fetch_add(p, v, __ATOMIC_RELAXED, __HIP_MEMORY_SCOPE_AGENT); }
__device__ __forceinline__ unsigned xb_xcc_id() { return (unsigned)__builtin_amdgcn_s_getreg((3 << 11) | 20) & 0xFu; }
#define XB_SPIN(cond, bar) do { unsigned _sp = 0; while (cond) { __builtin_amdgcn_s_sleep(1); \
    if ((++_sp & 255u) == 0u) { if (xb_ld(&(bar)[XB_TMO])) break; if (_sp > XB_SPIN_CAP) { atomicAdd(&(bar)[XB_TMO], 1u); break; } } } } while (0)

struct XcdBarrier {
    unsigned* bar; unsigned x; unsigned wave;
    volatile LAS unsigned* st;
};

__device__ __forceinline__ XcdBarrier xcd_barrier_post(unsigned* bar, volatile LAS unsigned* st, unsigned wave) {
    XcdBarrier b; b.bar = bar; b.x = xb_xcc_id(); b.st = st; b.wave = wave;
    if (MK_TID(wave) == 0) (void)xb_add(&bar[XB_XCNT(b.x)], 1u);
    return b;
}
__device__ __forceinline__ void xcd_barrier_complete(unsigned* bar, unsigned x, unsigned& nloc, unsigned& nx) {
    const unsigned G = gridDim.x * gridDim.y * gridDim.z;
    unsigned sum, cnt, mine, sp = 0u;
    for (;;) {
        sum = 0u; cnt = 0u; mine = 0u;
#pragma unroll
        for (unsigned j = 0; j < 16; ++j) { const unsigned c = xb_ld(&bar[XB_XCNT(j)]); sum += c; cnt += (c > 0u) ? 1u : 0u; mine = (j == x) ? c : mine; }
        if (sum == G) break;
        __builtin_amdgcn_s_sleep(1);
        if ((++sp & 255u) == 0u) { if (xb_ld(&bar[XB_TMO])) break; if (sp > XB_SPIN_CAP) { atomicAdd(&bar[XB_TMO], 1u); break; } }
    }
    nloc = mine > 0u ? mine : 1u; nx = cnt > 0u ? cnt : 1u;
}

__device__ __forceinline__ void xcd_barrier(const XcdBarrier& b) {
    asm volatile("s_waitcnt vmcnt(0)" ::: "memory");
    __syncthreads();
    if (MK_TID(b.wave) == 0) {
        __attribute__((address_space(1))) unsigned* barg = (__attribute__((address_space(1))) unsigned*)b.bar; asm volatile("" : "+s"(barg)); unsigned* bar = (unsigned*)barg;
        __builtin_amdgcn_s_waitcnt(0);
        unsigned nloc = b.st[0], nx = b.st[1];
        if (nloc == 0u) { xcd_barrier_complete(bar, b.x, nloc, nx); b.st[0] = nloc; b.st[1] = nx; }
        const unsigned old = xb_add(&bar[XB_XSUB(b.x)], 1u);
        const unsigned gen = old / nloc;
        if (old + 1u == (gen + 1u) * nloc) {
            __builtin_amdgcn_fence(__ATOMIC_RELEASE, "agent");
            asm volatile("s_waitcnt vmcnt(0)" ::: "memory");
            const unsigned og = xb_add(&bar[XB_TOP], 1u);
            const unsigned tg = og / nx;
            if (og + 1u == (tg + 1u) * nx) xb_add(&bar[XB_TOPGEN], 1u);
            else XB_SPIN(xb_ld(&bar[XB_TOPGEN]) == tg, bar);
            __builtin_amdgcn_fence(__ATOMIC_ACQUIRE, "agent");
            xb_add(&bar[XB_XGEN(b.x)], 1u);
            asm volatile("s_waitcnt vmcnt(0)" ::: "memory");
        } else {
            XB_SPIN(xb_ld(&bar[XB_XGEN(b.x)]) == gen, bar);
            __builtin_amdgcn_fence(__ATOMIC_ACQUIRE, "agent");
            asm volatile("s_waitcnt vmcnt(0)" ::: "memory");
        }
    }
    __syncthreads();
}

struct Frame {
    LAS unsigned char* lds;
    int wave, gw, ngw;
    float* X;
    unsigned char* ws;
};
typedef const __attribute__((address_space(4))) char* kptr_t;
__device__ __forceinline__ const float* in_ptr(int k) {
    kptr_t kp = (kptr_t)__builtin_amdgcn_kernarg_segment_ptr(); asm volatile("" : "+s"(kp));
    return *(const float* const __attribute__((address_space(4)))*)(kp + 8 * k);
}
__device__ __forceinline__ unsigned char* ws_fresh(unsigned char* w) { GAS unsigned char* g = (GAS unsigned char*)w; asm volatile("" : "+s"(g)); return (unsigned char*)g; }
#define WSP(T, off) ((T*)(ws_fresh(F.ws) + (off)))
__device__ __forceinline__ int fresh_tid_w(int wave) { int t = MK_TID(wave); asm volatile("" : "+v"(t)); return t; }
#define fresh_tid() fresh_tid_w(F.wave)
__device__ __forceinline__ float wave_sum(float v) {
#pragma unroll
    for (int o = 1; o < 64; o <<= 1) v += __shfl_xor(v, o);
    return v;
}
__device__ __forceinline__ float wave_max(float v) {
#pragma unroll
    for (int o = 1; o < 64; o <<= 1) v = fmaxf(v, __shfl_xor(v, o));
    return v;
}
constexpr int TR_SCR_BYTES = 64 * 65 * 4;
constexpr int TR_NGU = (DM / 64) * (FF / 64), TR_NIN = (DM / 64) * (NQKV / 64), TR_NOUT = (DM / 64) * (DM / 64);
constexpr int TR_ITEMS_LAYER = 6 * TR_NGU + TR_NIN + TR_NOUT;
constexpr int TR_ITEMS = DEPTH * TR_ITEMS_LAYER;
constexpr int TR_CHUNK = TR_ITEMS_LAYER / 2;
constexpr int TR_PRO = TR_ITEMS_LAYER - TR_CHUNK - (FF / 64) * (DM / 64);
static_assert(TR_PRO >= 2 * (DM / 64) * (FF / 64) && TR_PRO + TR_CHUNK >= 3 * (DM / 64) * (FF / 64) && TR_PRO + 8 * TR_CHUNK >= TR_ITEMS, "conversion schedule");
struct TrDesc { const float* src; const float* gain; bf16* dst; int ldw, K; };
__device__ __forceinline__ void tr_decode(Frame& F, int g, TrDesc& d) {
    const int l = g / TR_ITEMS_LAYER; int r = g - l * TR_ITEMS_LAYER;
    unsigned char* wl = F.ws + WS_W + (size_t)l * W_LAYER;
    const size_t offGU = (size_t)l * DM * FF;
    const float* W; const float* gn; bf16* dst; int ldw, nblk, K, up = 0, gated = 0;
    if (r < 3 * TR_NGU) {
        if (r < 2 * TR_NGU) { up = r >= TR_NGU; r -= up * TR_NGU; W = in_ptr(up ? 5 : 4) + offGU; ldw = FF; nblk = FF / 64; gn = in_ptr(1) + l * DM; K = DM; dst = (bf16*)(wl + W_GU0); gated = 1; }
        else { r -= 2 * TR_NGU; W = in_ptr(6) + offGU; ldw = DM; nblk = DM / 64; gn = nullptr; K = FF; dst = (bf16*)(wl + W_D0); }
    } else if (r < 3 * TR_NGU + TR_NIN + TR_NOUT) {
        const int kind = l % 3, j = l / 3; r -= 3 * TR_NGU;
        if (r < TR_NIN) { ldw = kind == 0 ? FOXN : NQKV; W = (kind == 0 ? in_ptr(10) : kind == 1 ? in_ptr(15) : in_ptr(18)) + (size_t)j * DM * ldw; nblk = NQKV / 64; gn = in_ptr(2) + l * DM; K = DM; dst = (bf16*)(wl + W_IN); }
        else { r -= TR_NIN; W = (kind == 0 ? in_ptr(14) : kind == 1 ? in_ptr(17) : in_ptr(19)) + (size_t)j * DM * DM; ldw = DM; nblk = DM / 64; gn = nullptr; K = DM; dst = (bf16*)(wl + W_OUT); }
    } else { r -= 3 * TR_NGU + TR_NIN + TR_NOUT;
        if (r < 2 * TR_NGU) { up = r >= TR_NGU; r -= up * TR_NGU; W = in_ptr(up ? 8 : 7) + offGU; ldw = FF; nblk = FF / 64; gn = in_ptr(3) + l * DM; K = DM; dst = (bf16*)(wl + W_GU1); gated = 1; }
        else { r -= 2 * TR_NGU; W = in_ptr(9) + offGU; ldw = DM; nblk = DM / 64; gn = nullptr; K = FF; dst = (bf16*)(wl + W_D1); }
    }
    const int kb = r / nblk, nb = r - kb * nblk, k0 = kb * 64, n0 = nb * 64;
    const int row = gated ? (((n0 >> 7) << 8) + (n0 & 127) + up * 128) : n0;
    d.src = W + (size_t)k0 * ldw + n0; d.gain = gn ? gn + k0 : nullptr; d.dst = dst + (size_t)row * K + k0; d.ldw = ldw; d.K = K;
}
__device__ __forceinline__ void tr_load(const TrDesc& d, f32x4 (&v)[16], f32x4 (&gv)[2], int lane) {
    const float* p = d.src + (size_t)(lane >> 4) * d.ldw + (lane & 15) * 4;
#pragma unroll
    for (int j = 0; j < 16; ++j) v[j] = __builtin_nontemporal_load((const f32x4*)(p + (size_t)(4 * j) * d.ldw));
    if (d.gain) { gv[0] = *(const f32x4*)(d.gain + 8 * (lane & 7)); gv[1] = *(const f32x4*)(d.gain + 8 * (lane & 7) + 4); }
    else { gv[0] = f32x4{1.f, 1.f, 1.f, 1.f}; gv[1] = gv[0]; }
}
__device__ __forceinline__ void tr_finish(const TrDesc& d, const f32x4 (&v)[16], const f32x4 (&gv)[2], LAS float* scr, int lane) {
    const int r0 = lane >> 4, c4 = (lane & 15) * 4;
#pragma unroll
    for (int j = 0; j < 16; ++j)
#pragma unroll
        for (int e = 0; e < 4; ++e) scr[(4 * j + r0) * 65 + c4 + e] = v[j][e];
    LDS_WAIT(); asm volatile("" ::: "memory");
    const int c = lane & 7;
#pragma unroll
    for (int j = 0; j < 8; ++j) { const int n = (lane >> 3) + 8 * j; const LAS float* s = scr + (8 * c) * 65 + n;
        v4u o; o.x = pg8::cvt_pk_bf16(s[0 * 65] * gv[0][0], s[1 * 65] * gv[0][1]); o.y = pg8::cvt_pk_bf16(s[2 * 65] * gv[0][2], s[3 * 65] * gv[0][3]);
        o.z = pg8::cvt_pk_bf16(s[4 * 65] * gv[1][0], s[5 * 65] * gv[1][1]); o.w = pg8::cvt_pk_bf16(s[6 * 65] * gv[1][2], s[7 * 65] * gv[1][3]);
        __builtin_nontemporal_store(o, (GAS v4u*)(d.dst + (size_t)n * d.K + 8 * c)); }
    LDS_WAIT(); asm volatile("" ::: "memory");
}
#define TR_WAIT_OLDER(dn, has) do { if (!(has)) asm volatile("s_waitcnt vmcnt(0)" ::: "memory"); else if ((dn).gain) asm volatile("s_waitcnt vmcnt(18)" ::: "memory"); else asm volatile("s_waitcnt vmcnt(16)" ::: "memory"); } while (0)
__device__ __forceinline__ void convert_range(Frame& F, int g0, int g1, int first, int stride) {
    const int lane = fresh_tid() & 63;
    LAS float* scr = (LAS float*)(F.lds + F.wave * TR_SCR_BYTES);
    const int it_end = g1 < TR_ITEMS ? g1 : TR_ITEMS;
    int it = g0 + first;
    if (it >= it_end) return;
    TrDesc dA, dB; f32x4 vA[16], vB[16], gA[2], gB[2];
    tr_decode(F, it, dA); tr_load(dA, vA, gA, lane);
    for (;;) {
        it += stride; const bool hasB = it < it_end;
        if (hasB) { tr_decode(F, it, dB); tr_load(dB, vB, gB, lane); }
        TR_WAIT_OLDER(dB, hasB); tr_finish(dA, vA, gA, scr, lane);
        if (!hasB) break;
        it += stride; const bool hasA = it < it_end;
        if (hasA) { tr_decode(F, it, dA); tr_load(dA, vA, gA, lane); }
        TR_WAIT_OLDER(dA, hasA); tr_finish(dB, vB, gB, scr, lane);
        if (!hasA) break;
    }
}
__device__ __forceinline__ void p_prologue(Frame& F, bool all_layers) {
    convert_range(F, 0, all_layers ? TR_ITEMS : TR_PRO, F.gw, F.ngw);
    const int lane = fresh_tid() & 63;
    for (int i = F.gw * 64 + lane; i < 2 * NH * DM; i += F.ngw * 64) { const int j = i / (NH * DM), r = i - j * NH * DM, h = r / DM, k = r - h * DM;
        WSP(bf16, WS_WFT)[i] = (bf16)f2bf(in_ptr(2)[(size_t)(3 * j) * DM + k] * in_ptr(10)[((size_t)j * DM + k) * FOXN + NQKV + h]); }
    const float* xin = in_ptr(0);
    for (int m = F.gw; m < SEQ; m += F.ngw) {
        const GAS f32x4* xr = (const GAS f32x4*)(xin + (size_t)m * DM) + lane;
        GAS v2u* xb = (GAS v2u*)(WSP(bf16, WS_XB) + (size_t)m * DM) + lane; float s = 0.f;
#pragma unroll
        for (int j = 0; j < 8; ++j) { const f32x4 v = xr[64 * j]; s += (v.x * v.x + v.y * v.y) + (v.z * v.z + v.w * v.w);
            v2u w; w.x = pk2(v.x, v.y); w.y = pk2(v.z, v.w); xb[64 * j] = w; }
        s = wave_sum(s);
        if (lane == 0) WSP(pg8::u64_t, WS_SS)[m] = (pg8::u64_t)(s * pg8::SS_FIX);
    }
}
__device__ __forceinline__ void p_fgate(Frame& F, int l, const pg8::u64_t* ss) {
    const int j = l / 3; const bf16* WT = WSP(bf16, WS_WFT) + (size_t)j * NH * DM; const float* bf = in_ptr(11) + j * NH;
    const int tid = fresh_tid(), lane = tid & 63, rg = F.wave >> 2, kq = F.wave & 3;
    LAS float* red = (LAS float*)F.lds;
    for (int tb = blockIdx.x; tb < SEQ / 32; tb += gridDim.x) {
        const bf16* xa = WSP(bf16, WS_XB) + (size_t)(tb * 32 + rg * 16 + (lane & 15)) * DM + kq * 512 + (lane >> 4) * 8;
        const bf16* wb = WT + (size_t)(lane & 15) * DM + kq * 512 + (lane >> 4) * 8;
        pg8::bf16x8 a[16], b[16];
#pragma unroll
        for (int s = 0; s < 16; ++s) { a[s] = *(const pg8::bf16x8*)(xa + s * 32); b[s] = *(const pg8::bf16x8*)(wb + s * 32); }
        f32x4 acc = {0.f, 0.f, 0.f, 0.f};
#pragma unroll
        for (int s = 0; s < 16; ++s) acc = __builtin_amdgcn_mfma_f32_16x16x32_bf16(a[s], b[s], acc, 0, 0, 0);
        *(LAS f32x4*)(red + (F.wave * 64 + lane) * 4) = acc;
        __syncthreads();
        { const int rg2 = tid >> 8, h = (tid >> 4) & 15, tk = tid & 15, t = tb * 32 + rg2 * 16 + tk;
          const LAS float* p = red + ((rg2 * 4) * 64 + (tk >> 2) * 16 + h) * 4 + (tk & 3);
          const float s = (p[0] + p[256]) + (p[512] + p[768]);
          const float rs = 1.0f / sqrtf((float)ss[t] * (pg8::SS_UNFIX / DM) + EPS);
          const float u = s * rs + bf[h];
          WSP(float, WS_LOGF)[(size_t)h * SEQ + t] = fminf(u, 0.f) - log1pf(expf(-fabsf(u))); }
        __syncthreads();
    }
}
__device__ __forceinline__ void p_conv(Frame& F, int l) {
    const float* ck = in_ptr(16) + (size_t)(l / 3) * 3 * DM; const int lane = fresh_tid() & 63;
    const bf16* Q = WSP(bf16, WS_QKV); bf16* O = WSP(bf16, WS_OB);
    for (int idx = F.gw * 64 + lane; idx < (SEQ / 16) * (DM / 8); idx += F.ngw * 64) {
        const int c = (idx & 255) * 8, t0 = (idx >> 8) * 16;
        float k0[8], k1[8], k2[8], p1[8], p2[8];
#pragma unroll
        for (int e8 = 0; e8 < 8; ++e8) { k0[e8] = ck[c + e8]; k1[e8] = ck[DM + c + e8]; k2[e8] = ck[2 * DM + c + e8]; p1[e8] = 0.f; p2[e8] = 0.f; }
        if (t0 > 0) {
#pragma unroll
            for (int d = 2; d >= 1; --d) { const bf16* r = Q + (size_t)(t0 - d) * NQKV + c; const v4u cg = *(const v4u*)(r + DM), uu = *(const v4u*)(r + 2 * DM);
#pragma unroll
                for (int e4 = 0; e4 < 4; ++e4) { const float a = bf_lo(cg[e4]) * bf_lo(uu[e4]), b2 = bf_hi(cg[e4]) * bf_hi(uu[e4]);
                    if (d == 2) { p2[2 * e4] = a; p2[2 * e4 + 1] = b2; } else { p1[2 * e4] = a; p1[2 * e4 + 1] = b2; } } } }
#pragma unroll 4
        for (int i = 0; i < 16; ++i) { const bf16* r = Q + (size_t)(t0 + i) * NQKV + c;
            const v4u bg = *(const v4u*)r, cg = *(const v4u*)(r + DM), uu = *(const v4u*)(r + 2 * DM); float y[8];
#pragma unroll
            for (int e4 = 0; e4 < 4; ++e4) { const float a = bf_lo(cg[e4]) * bf_lo(uu[e4]), b2 = bf_hi(cg[e4]) * bf_hi(uu[e4]);
                y[2 * e4] = bf_lo(bg[e4]) * (k0[2 * e4] * p2[2 * e4] + k1[2 * e4] * p1[2 * e4] + k2[2 * e4] * a);
                y[2 * e4 + 1] = bf_hi(bg[e4]) * (k0[2 * e4 + 1] * p2[2 * e4 + 1] + k1[2 * e4 + 1] * p1[2 * e4 + 1] + k2[2 * e4 + 1] * b2);
                p2[2 * e4] = p1[2 * e4]; p2[2 * e4 + 1] = p1[2 * e4 + 1]; p1[2 * e4] = a; p1[2 * e4 + 1] = b2; }
            v4u o; o.x = pk2(y[0], y[1]); o.y = pk2(y[2], y[3]); o.z = pk2(y[4], y[5]); o.w = pk2(y[6], y[7]);
            *(v4u*)(O + (size_t)(t0 + i) * DM + c) = o; }
    }
}
template <int KIND>
__device__ __forceinline__ void p_attn_naive(Frame& F) {
    const int lane = fresh_tid() & 63;
    for (int p = F.gw; p < SEQ * NH; p += F.ngw) {
        const int h = p & 15, t = p >> 4;
        const bf16* Qr = WSP(bf16, WS_QKV) + (size_t)t * NQKV + h * HD; const bf16* Kh = WSP(bf16, WS_QKV) + DM + h * HD; const bf16* Vh = WSP(bf16, WS_QKV) + 2 * DM + h * HD + 2 * lane;
        LAS float* q = (LAS float*)(F.lds + F.wave * 1024);
        { const unsigned w = *(const unsigned*)(Qr + 2 * lane); asm volatile("" ::: "memory"); q[2 * lane] = bf_lo(w); q[2 * lane + 1] = bf_hi(w); LDS_WAIT(); asm volatile("" ::: "memory"); }
        float o0 = 0.f, o1 = 0.f;
        if (KIND == 0) {
            const float* cn = WSP(float, WS_CNEG) + (size_t)h * SEQ; const float cnt = cn[t];
            float m = -1e30f, lsum = 0.f; const int nt = t / 64 + 1;
            for (int jt = 0; jt < nt; ++jt) { asm volatile("" ::: "memory"); const int s0 = jt * 64, s = s0 + lane; const bf16* kr = Kh + (size_t)s * NQKV; float dot = 0.f;
#pragma unroll
                for (int c = 0; c < 16; ++c) { const v4u w = *(const v4u*)(kr + 8 * c);
#pragma unroll
                    for (int e = 0; e < 4; ++e) dot += q[8 * c + 2 * e] * bf_lo(w[e]) + q[8 * c + 2 * e + 1] * bf_hi(w[e]); }
                float sc = dot + (cn[s] - cnt); if (s > t) sc = -__builtin_inff();
                const float mn = fmaxf(m, wave_max(sc)); const float pr = exp2f(sc - mn), al = exp2f(m - mn);
                lsum = lsum * al + wave_sum(pr); o0 *= al; o1 *= al; m = mn;
#pragma unroll 8
                for (int jj = 0; jj < 64; ++jj) { const float pj = __int_as_float(__builtin_amdgcn_readlane(__float_as_int(pr), jj));
                    const unsigned vv = *(const unsigned*)(Vh + (size_t)(s0 + jj) * NQKV); o0 += pj * bf_lo(vv); o1 += pj * bf_hi(vv); } }
            const float il = 1.0f / lsum; o0 *= il; o1 *= il;
        } else {
            float R = 0.f;
            for (int jt = (t - 1) >> 6; jt >= 0 && t > 0 && R > -200.f; --jt) {     asm volatile("" ::: "memory"); const int s0 = jt * 64, s = s0 + lane; const bf16* kr = Kh + (size_t)s * NQKV; float z = 0.f;
#pragma unroll
                for (int c = 0; c < 16; ++c) { const v4u w = *(const v4u*)(kr + 8 * c);
#pragma unroll
                    for (int e = 0; e < 4; ++e) z += q[8 * c + 2 * e] * bf_lo(w[e]) + q[8 * c + 2 * e + 1] * bf_hi(w[e]); }
                const bool valid = s < t;
                const float ls = fminf(z, 0.f) - log2f(1.0f + exp2f(-fabsf(z)));
                const float lom = valid ? ls - z : 0.f;
                float inc = lom;
#pragma unroll
                for (int o = 1; o < 64; o <<= 1) { const float tv = __shfl_down(inc, o); if (lane + o < 64) inc += tv; }
                const float a = valid ? exp2f(ls + R + (inc - lom)) : 0.f;
                R += __int_as_float(__builtin_amdgcn_readlane(__float_as_int(inc), 0));
#pragma unroll 8
                for (int jj = 0; jj < 64; ++jj) { const float pj = __int_as_float(__builtin_amdgcn_readlane(__float_as_int(a), jj));
                    const unsigned vv = *(const unsigned*)(Vh + (size_t)(s0 + jj) * NQKV); o0 += pj * bf_lo(vv); o1 += pj * bf_hi(vv); } }
        }
        *(unsigned*)(WSP(bf16, WS_OB) + (size_t)t * DM + h * HD + 2 * lane) = pk2(o0, o1);
    }
}

struct Args { const float* in[20]; float* out; unsigned char* ws; int ph_lo, ph_hi; };
__global__ void __launch_bounds__(NWAVES * 64, 2) mk_fwd(Args args) {
    extern __shared__ __attribute__((aligned(16))) unsigned char lds[];
    Frame F;
    F.lds = (LAS unsigned char*)lds;
    F.wave = __builtin_amdgcn_readfirstlane((int)threadIdx.x >> 6);
    F.gw = blockIdx.x * NWAVES + F.wave; F.ngw = gridDim.x * NWAVES;
    F.X = args.out; F.ws = args.ws;
    for (int u = threadIdx.x; u < (LDS_BYTES - LDSCTL_OFF) / 4; u += NWAVES * 64) ((LAS unsigned*)(F.lds + LDSCTL_OFF))[u] = 0u;
    __syncthreads();
    const int lo = args.ph_lo, hi = args.ph_hi;
    unsigned* barw = (unsigned*)(args.ws + WS_CTL) + CW_BAR;
    XcdBarrier bar; bar.bar = barw; bar.x = 0; bar.st = nullptr; bar.wave = (unsigned)F.wave;
    if (hi - lo > 1) bar = xcd_barrier_post(barw, (volatile LAS unsigned*)(F.lds + MISC_OFF) + 8, (unsigned)F.wave);
    const int G = gridDim.x, bid = blockIdx.x;
    const bool inphase_conv = (G == 256);
    int ph = 0;
#define RUN() (lo <= ph && ph < hi)
#define SEAM() do { if (lo <= ph && ph + 1 < hi) { if (((MK_PROBE >> 9) & 1) && MK_TID(F.wave) == 0) { asm volatile("s_waitcnt vmcnt(0)" ::: "memory"); __builtin_amdgcn_fence(__ATOMIC_RELEASE, "agent"); } xcd_barrier(bar); if ((MK_PROBE >> 6) & 1) xcd_barrier(bar); } ++ph; } while (0)

    if (RUN()) { _Pragma("unroll 1") for (int rep = 0; rep < 1 + ((MK_PROBE >> 0) & 1); ++rep) p_prologue(F, !inphase_conv); }
    SEAM();
    for (int f = 0; f < 2 * DEPTH; ++f) {
        const int l = f >> 1, sub = f & 1, nidx = 3 * l + (sub ? 2 : 0);
        unsigned char* wl = args.ws + WS_W + (size_t)l * W_LAYER;
        if (RUN()) {
            pg8::Gemm g{WSP(bf16, WS_XB), (const bf16*)(wl + (sub ? W_GU1 : W_GU0)), SEQ, 2 * FF, DM}; pg8::StaticOrder S; S.init(SEQ, 2 * FF, G, bid);
            pg8::EpiSwiglu E{WSP(bf16, WS_ACT), FF, (MK_RELAUNCH_SCHED == 7 && hi - lo == 1) ? (const pg8::u64_t*)nullptr : WSP(pg8::u64_t, WS_SS) + (size_t)nidx * SEQ};
#if MK_STAMP
            if (f == 3 && blockIdx.x == 0 && MK_TID(F.wave) == 0) { unsigned long long* sp = WSP(unsigned long long, WS_CTL + 786432); sp[0] = __builtin_amdgcn_s_memtime(); sp[1] = __builtin_amdgcn_s_memrealtime(); }
#endif
            pg8::gemm_phase<pg8::EpiSwiglu, pg8::StaticOrder, true, true>(F.lds, g, S, E, F.wave);
            if (inphase_conv && bid >= 128) convert_range(F, TR_PRO + f * TR_CHUNK, TR_PRO + (f + 1) * TR_CHUNK, (bid - 128) * NWAVES + F.wave, 128 * NWAVES);
#if MK_STAMP
            if (f == 3 && blockIdx.x == 0 && MK_TID(F.wave) == 0) { unsigned long long* sp = WSP(unsigned long long, WS_CTL + 786432); sp[2] = __builtin_amdgcn_s_memtime(); sp[3] = __builtin_amdgcn_s_memrealtime(); }
#endif
        }
        SEAM();
        if (RUN()) {
            pg8::Gemm g{WSP(bf16, WS_ACT), (const bf16*)(wl + (sub ? W_D1 : W_D0)), SEQ, DM, FF}; pg8::StaticOrder S; S.init(SEQ, DM, G, bid);
            pg8::EpiResid E{(f == 2 * DEPTH - 1) ? F.X : (float*)nullptr, WSP(bf16, WS_XB), WSP(pg8::u64_t, WS_SS) + (size_t)(nidx + 1) * SEQ, 0.5f};
#if (MK_PROBE >> 4) & 1
            { pg8::EpiResid E0{(float*)nullptr, WSP(bf16, WS_XB), WSP(pg8::u64_t, WS_SS) + (size_t)13 * SEQ, 0.0f}; pg8::gemm_phase<pg8::EpiResid, pg8::StaticOrder, true, true>(F.lds, g, S, E0, F.wave); }
#endif
            pg8::gemm_phase<pg8::EpiResid, pg8::StaticOrder, true, true>(F.lds, g, S, E, F.wave);
        }
        SEAM();
        if (sub == 0) {
            const int kind = l % 3; const pg8::u64_t* ssm = WSP(pg8::u64_t, WS_SS) + (size_t)(3 * l + 1) * SEQ;
            if (RUN()) {
                pg8::Gemm g{WSP(bf16, WS_XB), (const bf16*)(wl + W_IN), SEQ, NQKV, DM}; pg8::StaticOrder S; S.init(SEQ, NQKV, G, bid);
                pg8::EpiQKV E{WSP(bf16, WS_QKV), NQKV, ssm, QSCALE, kind == 2 ? DM / 256 : 0, kind == 0 ? in_ptr(12) + (l / 3) * HD : (const float*)nullptr, kind == 0 ? in_ptr(13) + (l / 3) * HD : (const float*)nullptr, (PG8_LAS float*)(F.lds + RING_BYTES)};
                _Pragma("unroll 1") for (int rep = 0; rep < 1 + ((MK_PROBE >> 3) & 1); ++rep) pg8::gemm_phase<pg8::EpiQKV, pg8::StaticOrder, true, true>(F.lds, g, S, E, F.wave);
                if (kind == 0) p_fgate(F, l, ssm);
            }
            SEAM();
            if (kind == 0) {
#if MK_NAIVE_ATTN
                if (RUN()) p_attn_naive<0>(F);
#else
                if (RUN()) { _Pragma("unroll 1") for (int rep = 0; rep < 1 + ((MK_PROBE >> 2) & 1); ++rep) att::attn_phase<0>((char*)lds, WSP(bf16, WS_QKV), WSP(bf16, WS_OB), WSP(float, WS_LOGF), in_ptr(12) + (l / 3) * HD, in_ptr(13) + (l / 3) * HD, F.wave, (hi - lo == 1) ? MK_RELAUNCH_SCHED : 0); }
#endif
                SEAM();
            } else if (kind == 1) {
                if (RUN()) { _Pragma("unroll 1") for (int rep = 0; rep < 1 + ((MK_PROBE >> 8) & 1); ++rep) p_conv(F, l); }
                SEAM();
            } else {
#if MK_NAIVE_ATTN
                if (RUN()) p_attn_naive<2>(F);
#else
                if (RUN()) { _Pragma("unroll 1") for (int rep = 0; rep < 1 + ((MK_PROBE >> 7) & 1); ++rep) att::attn_phase<2>((char*)lds, WSP(bf16, WS_QKV), WSP(bf16, WS_OB), WSP(float, WS_LOGF), (const float*)nullptr, (const float*)nullptr, F.wave); }
#endif
                SEAM();
            }
            if (RUN()) {
                pg8::Gemm g{WSP(bf16, WS_OB), (const bf16*)(wl + W_OUT), SEQ, DM, DM}; pg8::StaticOrder S; S.init(SEQ, DM, G, bid);
                pg8::EpiResid E{(float*)nullptr, WSP(bf16, WS_XB), WSP(pg8::u64_t, WS_SS) + (size_t)(3 * l + 2) * SEQ, 1.0f};
#if (MK_PROBE >> 5) & 1
                { pg8::EpiResid E0{(float*)nullptr, WSP(bf16, WS_XB), WSP(pg8::u64_t, WS_SS) + (size_t)13 * SEQ, 0.0f}; pg8::gemm_phase<pg8::EpiResid, pg8::StaticOrder, true, true>(F.lds, g, S, E0, F.wave); }
#endif
                pg8::gemm_phase<pg8::EpiResid, pg8::StaticOrder, true, true>(F.lds, g, S, E, F.wave);
            }
            SEAM();
        }
    }
#if MK_STAMP
    xcd_barrier(bar);
    if (blockIdx.x == 0 && MK_TID(F.wave) == 0) { const unsigned long long* sp = WSP(unsigned long long, WS_CTL + 786432); const float stamp_dc = (float)(sp[2] - sp[0]), stamp_dr = (float)(sp[3] - sp[1]); F.X[0] = 1000.0f * floorf((MK_STAMP == 1) ? (stamp_dc / stamp_dr * 100.0f / 500.0f)   : (stamp_dc / (6.0f * 32.0f) / 500.0f))  ; }
#endif
#undef RUN
#undef SEAM
}

extern "C" void kernel_launch(void* const* d_in, const int* in_sizes, int n_in, void* d_out, int out_size, void* d_ws, size_t ws_size, hipStream_t stream) {
    static int grid = 0;
    if (grid == 0) {
        if (n_in != 20 || in_sizes[0] != SEQ * DM || out_size != SEQ * DM || ws_size < WS_END) {
            fprintf(stderr, "kernel_launch: unexpected shapes (n_in %d, in0 %d, out %d, ws %zu; need ws >= %zu); nothing launched\n", n_in, n_in > 0 ? in_sizes[0] : -1, out_size, ws_size, (size_t)WS_END); grid = -1; return; }
        int dev = 0, cus = 0, per_cu = 0;
        if (hipGetDevice(&dev) != hipSuccess || hipDeviceGetAttribute(&cus, hipDeviceAttributeMultiprocessorCount, dev) != hipSuccess) { grid = -1; return; }
        if (hipFuncSetAttribute((const void*)mk_fwd, hipFuncAttributeMaxDynamicSharedMemorySize, LDS_BYTES) != hipSuccess) { fprintf(stderr, "kernel_launch: hipFuncSetAttribute failed\n"); grid = -1; return; }
        if (hipOccupancyMaxActiveBlocksPerMultiprocessor(&per_cu, (const void*)mk_fwd, NWAVES * 64, LDS_BYTES) != hipSuccess || per_cu < 1)
            fprintf(stderr, "kernel_launch: note: occupancy query reports %d workgroups per CU\n", per_cu);
        (void)hipGetLastError();
        grid = cus;
    }
    if (grid < 0) return;
    if (hipMemsetAsync((char*)d_ws + WS_CTL, 0, CTL_ZERO_BYTES, stream) != hipSuccess) { fprintf(stderr, "kernel_launch: memset failed\n"); return; }
    Args a{};
    for (int i = 0; i < 20; ++i) a.in[i] = (const float*)d_in[i];
    a.out = (float*)d_out; a.ws = (unsigned char*)d_ws;
#if MK_ONE_LAUNCH
    a.ph_lo = 0; a.ph_hi = N_PHASES;
    hipLaunchKernelGGL(mk_fwd, dim3(grid), dim3(NWAVES * 64), LDS_BYTES, stream, a);
#if MK_RELAUNCH >= 0
    for (int r = 0; r < MK_RELAUNCH_N; ++r) { if (MK_RELAUNCH_SPAN > 1) (void)hipMemsetAsync((char*)d_ws + WS_CTL + CW_BAR * 4, 0, XCD_BAR_WORDS * 4, stream); a.ph_lo = MK_RELAUNCH; a.ph_hi = MK_RELAUNCH + MK_RELAUNCH_SPAN; hipLaunchKernelGGL(mk_fwd, dim3(grid), dim3(NWAVES * 64), LDS_BYTES, stream, a); }
#endif
#else
    for (int p = 0; p < N_PHASES; ++p) { a.ph_lo = p; a.ph_hi = p + 1;
        hipLaunchKernelGGL(mk_fwd, dim3(grid), dim3(NWAVES * 64), LDS_BYTES, stream, a); }
#endif
    const hipError_t le = hipPeekAtLastError();
    if (le != hipSuccess) fprintf(stderr, "kernel_launch: launch failed: %s\n", hipGetErrorName(le));
}
```
